# Optimizing an MI355X kernel written in HIP

```python
import math
import jax, jax.numpy as jnp
from jax import lax
import numpy as np

D_MODEL = 2048
BATCH = 1
SEQ = 8192
DEPTH = 4

CHUNK = 64
HGRN_HEADS = 8
HGRN_KDIM = 128
HGRN_VDIM = 128
HGRN_KWIDTH = HGRN_HEADS * HGRN_KDIM
HGRN_VWIDTH = HGRN_HEADS * HGRN_VDIM
DIFF_HEADS = 4
DIFF_HEAD_DIM = 128
DIFF_V_DIM = 2 * DIFF_HEAD_DIM
DIFF_QK_WIDTH = DIFF_HEADS * 2 * DIFF_HEAD_DIM
DIFF_V_WIDTH = DIFF_HEADS * DIFF_V_DIM
ROPE_THETA = 500000.0
ROPE_DIM = DIFF_HEAD_DIM // 4
Q_BLOCK = 128
FFN_HIDDEN = -(-8 * D_MODEL // (3 * 256)) * 256
IN_WIDTHS = (HGRN_KWIDTH, HGRN_KWIDTH, HGRN_VWIDTH, HGRN_VWIDTH,
             DIFF_QK_WIDTH, DIFF_QK_WIDTH, DIFF_V_WIDTH, D_MODEL, D_MODEL)
IN_TOTAL = sum(IN_WIDTHS)
NORM_EPS = 1e-6
SUBLN_EPS = 1e-5

kernel_name = "hgrn2_diffattn_gated_hybrid"


def rms_norm(x, w, eps=NORM_EPS):
    xf = x.astype(jnp.float32)
    y = xf * lax.rsqrt(jnp.mean(xf * xf, axis=-1, keepdims=True) + eps)
    return (y * w.astype(jnp.float32)).astype(x.dtype)


def split_indices():
    idx, acc = [], 0
    for w in IN_WIDTHS[:-1]:
        acc += w
        idx.append(acc)
    return idx


def rope_tables(seq):
    pos = jnp.arange(seq, dtype=jnp.float32)
    inv_freq = ROPE_THETA ** (-jnp.arange(0, ROPE_DIM, 2, dtype=jnp.float32) / ROPE_DIM)
    ang = pos[:, None] * inv_freq[None, :]
    return jnp.cos(ang), jnp.sin(ang)


def partial_rope(t, cos, sin):
    half = ROPE_DIM // 2
    c = cos[None, :, None, None, :]
    s = sin[None, :, None, None, :]
    t1 = t[..., :half].astype(jnp.float32)
    t2 = t[..., half:ROPE_DIM].astype(jnp.float32)
    out = jnp.concatenate([t1 * c - t2 * s, t2 * c + t1 * s,
                           t[..., ROPE_DIM:].astype(jnp.float32)], axis=-1)
    return out.astype(t.dtype)


def hgrn2_mixer(q_raw, f_raw, i_raw, g_raw, lb, gnorm_w):
    B, S, _ = q_raw.shape
    dt = q_raw.dtype
    H, K, V = HGRN_HEADS, HGRN_KDIM, HGRN_VDIM
    q = jax.nn.silu(q_raw.astype(jnp.float32)).reshape(B, S, H, K)
    fr = f_raw.astype(jnp.float32).reshape(B, S, H, K)
    log_lb = jnp.log(jnp.maximum(lb.astype(jnp.float32), jnp.finfo(jnp.float32).tiny)).reshape(H, K)
    log_f = jax.nn.log_sigmoid(fr) + jax.nn.softplus(log_lb - fr)
    k = -jnp.expm1(log_f)
    v = i_raw.astype(jnp.float32).reshape(B, S, H, V)
    nc = S // CHUNK

    def to_chunks(t):
        return t.reshape(B, nc, CHUNK, H, t.shape[-1]).transpose(1, 0, 3, 2, 4)

    causal = jnp.tril(jnp.ones((CHUNK, CHUNK), dtype=bool))

    def step(state, xs):
        qc, kc, vc, lfc = xs
        G = jnp.cumsum(lfc, axis=2)
        diff = G[:, :, :, None, :] - G[:, :, None, :, :]
        decay = jnp.exp(jnp.where(causal[:, :, None], diff, -jnp.inf))
        A = jnp.einsum('bhtk,bhsk,bhtsk->bhts', qc, kc, decay)
        o = (jnp.einsum('bhts,bhsv->bhtv', A, vc)
             + jnp.einsum('bhtk,bhkv->bhtv', qc * jnp.exp(G), state))
        G_last = G[:, :, -1:, :]
        state = (jnp.exp(G_last[:, :, 0, :])[..., None] * state
                 + jnp.einsum('bhsk,bhsv->bhkv', kc * jnp.exp(G_last - G), vc))
        return state, o

    s0 = jnp.zeros((B, H, K, V), jnp.float32)
    _, o = lax.scan(step, s0, (to_chunks(q), to_chunks(k), to_chunks(v), to_chunks(log_f)))
    o = o.transpose(1, 0, 3, 2, 4).reshape(B, S, H, V)
    g = g_raw.astype(jnp.float32).reshape(B, S, H, V)
    o = o * lax.rsqrt(jnp.mean(o * o, axis=-1, keepdims=True) + NORM_EPS)
    o = o * gnorm_w.astype(jnp.float32) * jax.nn.silu(g)
    return o.reshape(B, S, H * V).astype(dt)


def diff_attention(q_raw, k_raw, v_raw, lam, lam_init, subln_w, cos, sin):
    B, S, _ = q_raw.shape
    H, d = DIFF_HEADS, DIFF_HEAD_DIM
    q = partial_rope(q_raw.reshape(B, S, H, 2, d), cos, sin) * (d ** -0.5)
    k = partial_rope(k_raw.reshape(B, S, H, 2, d), cos, sin)
    v = v_raw.reshape(B, S, H, DIFF_V_DIM)
    nb = S // Q_BLOCK
    q_blocks = q.reshape(B, nb, Q_BLOCK, H, 2, d).transpose(1, 0, 2, 3, 4, 5)
    k_chunk = jnp.arange(S) // CHUNK
    q_chunk_blocks = k_chunk.reshape(nb, Q_BLOCK)

    def attend(args):
        qblk, qch = args
        s = jnp.einsum('bqhcd,bkhcd->bhcqk', qblk, k).astype(jnp.float32)
        mask = qch[:, None] >= k_chunk[None, :]
        p = jax.nn.softmax(jnp.where(mask, s, -jnp.inf), axis=-1)
        attn = (p[:, :, 0] - lam * p[:, :, 1]).astype(v.dtype)
        return jnp.einsum('bhqk,bkhe->bqhe', attn, v)

    o = lax.map(attend, (q_blocks, q_chunk_blocks))
    o = o.transpose(1, 0, 2, 3, 4).reshape(B, S, H, DIFF_V_DIM)
    o = rms_norm(o, subln_w, eps=SUBLN_EPS) * (1.0 - lam_init)
    return o.reshape(B, S, H * DIFF_V_DIM)


def setup_inputs(seed: int = 0) -> dict:
    key = jax.random.key(seed)
    ks = jax.random.split(key, 13)
    f32 = jnp.float32
    nrm = lambda k, shape, scale: jax.random.normal(k, shape, f32) * scale
    return {
        "x": nrm(ks[0], (BATCH, SEQ, D_MODEL), 1.0),
        "w_in": nrm(ks[1], (DEPTH, D_MODEL, IN_TOTAL), D_MODEL ** -0.5),
        "hgrn_lower_bounds": nrm(ks[2], (DEPTH, HGRN_KWIDTH), 0.5),
        "hgrn_gnorm_w": 1.0 + nrm(ks[3], (DEPTH, HGRN_VDIM), 0.02),
        "diff_lambda": nrm(ks[4], (DEPTH, 4, DIFF_HEAD_DIM), 0.1),
        "diff_subln_w": 1.0 + nrm(ks[5], (DEPTH, DIFF_V_DIM), 0.02),
        "w_branch_a": nrm(ks[6], (DEPTH, HGRN_VWIDTH, D_MODEL), HGRN_VWIDTH ** -0.5),
        "w_branch_b": nrm(ks[7], (DEPTH, DIFF_V_WIDTH, D_MODEL), DIFF_V_WIDTH ** -0.5),
        "w_out": nrm(ks[8], (DEPTH, D_MODEL, D_MODEL), D_MODEL ** -0.5),
        "norm_w": 1.0 + nrm(ks[9], (DEPTH, 4, D_MODEL), 0.02),
        "w_ffn_in": nrm(ks[10], (DEPTH, D_MODEL, 2 * FFN_HIDDEN), D_MODEL ** -0.5),
        "w_ffn_out": nrm(ks[11], (DEPTH, FFN_HIDDEN, D_MODEL), FFN_HIDDEN ** -0.5),
    }


def reference(x, w_in, hgrn_lower_bounds, hgrn_gnorm_w, diff_lambda, diff_subln_w,
              w_branch_a, w_branch_b, w_out, norm_w, w_ffn_in, w_ffn_out):
    S = x.shape[1]
    cos, sin = rope_tables(S)
    lb_p = jax.nn.softmax(hgrn_lower_bounds.astype(jnp.float32), axis=0)
    lb_all = jnp.cumsum(lb_p, axis=0) - lb_p[0:1]
    splits = split_indices()
    for l in range(DEPTH):
        nw = norm_w[l]
        h = rms_norm(x, nw[0])
        proj = h @ w_in[l]
        hq, hf, hi, hg, dq, dk, dv, ga, gb = jnp.split(proj, splits, axis=-1)
        y_a = hgrn2_mixer(hq, hf, hi, hg, lb_all[l], hgrn_gnorm_w[l]) @ w_branch_a[l]
        lam_init = 0.8 - 0.6 * math.exp(-0.3 * l)
        lp = diff_lambda[l].astype(jnp.float32)
        lam = jnp.exp(jnp.sum(lp[0] * lp[1])) - jnp.exp(jnp.sum(lp[2] * lp[3])) + lam_init
        y_b = diff_attention(dq, dk, dv, lam, lam_init, diff_subln_w[l], cos, sin) @ w_branch_b[l]
        merged = jax.nn.sigmoid(ga) * y_a + jax.nn.sigmoid(gb) * y_b
        x = x + rms_norm(merged @ w_out[l], nw[1])
        h = rms_norm(x, nw[2])
        gate, up = jnp.split(h @ w_ffn_in[l], 2, axis=-1)
        x = x + rms_norm((jax.nn.silu(gate) * up) @ w_ffn_out[l], nw[3])
    return x
```

```cpp
#include <hip/hip_runtime.h>
#include <hip/hip_bf16.h>
#include <cstdio>
#include <cstdint>
#ifndef MK_PER_PHASE
#define MK_PER_PHASE 0
#endif
namespace pg8 {
#define PG8_LAS __attribute__((address_space(3)))
typedef unsigned short bf16_t;
typedef short bf16x8 __attribute__((ext_vector_type(8)));
typedef float f32x4 __attribute__((ext_vector_type(4)));
typedef unsigned u32x4 __attribute__((ext_vector_type(4)));
constexpr int BM = 256, BK = 64, HALF = 128, HTB = HALF * BK * 2  , STAGE_BYTES = 8 * HTB, NXCD = 8, WGM = 8;

__host__ __device__ __forceinline__ int lds_byte(int r, int c) { const int st = (r >> 4) * 2 + (c >> 5), rr = r & 15, cc = c & 31, ob = rr * 64 + cc * 2; return st * 1024 + (ob ^ (((ob >> 9) & 1) << 5)); }
__host__ __device__ __forceinline__ void stage_rc(int b, int& R, int& C) { const int st = b / 1024, sb = b % 1024, swz = sb ^ (((sb >> 9) & 1) << 5); R = (st >> 1) * 16 + swz / 64; C = (st & 1) * 32 + (swz % 64) / 2; }
__host__ __device__ __forceinline__ int perm32(int rho) { const int n = rho >> 4, i = rho & 15; return 8 * (i >> 2) + 4 * n + (i & 3); }

struct Unit { int pm, pn; };
struct Gemm { const bf16_t* A; const bf16_t* Bt; int M, N, K; };

struct StaticOrder {
    int nM, nN, nwg, G, c;
    __host__ __device__ void init(int M, int N, int G_, int c_) { nM = M / BM; nN = N / BM; nwg = nM * nN; G = G_; c = c_; }
    __host__ __device__ bool next(int i, Unit& u) const {
        const long L = (long)i * G + c; if (L >= nwg) return false;
        int wgid = (int)L; { const int q = nwg / NXCD, r = nwg % NXCD, xcd = wgid % NXCD, off = wgid / NXCD; wgid = (xcd < r ? xcd * (q + 1) : r * (q + 1) + (xcd - r) * q) + off; }
        const int nig = WGM * nN, gid = wgid / nig, fm = gid * WGM, gsz = (nM - fm) < WGM ? (nM - fm) : WGM;
        u.pm = fm + ((wgid % nig) % gsz); u.pn = (wgid % nig) / gsz; return true;
    }
    __device__ __forceinline__ void a_ready(const Unit&) const {}
    __device__ __forceinline__ void done(const Unit&) const {}
};
typedef float f32x2_t __attribute__((ext_vector_type(2))); typedef __bf16 bf16x2_t __attribute__((ext_vector_type(2)));
__device__ __forceinline__ unsigned cvt_pk_bf16(float lo, float hi) { f32x2_t v = {lo, hi}; bf16x2_t b = __builtin_convertvector(v, bf16x2_t); return __builtin_bit_cast(unsigned, b); }
typedef float f32x2 __attribute__((ext_vector_type(2)));
template <class Epi, class Sched, bool ALIGN_EPI = false, bool SP2 = false>
__device__ __forceinline__ void gemm_phase(PG8_LAS unsigned char* lds, const Gemm g, const Sched& S, const Epi& E) {
    int tid_o = threadIdx.x; asm volatile("" : "+v"(tid_o));
    const int tid = tid_o, wid = __builtin_amdgcn_readfirstlane(tid >> 6), lane = tid & 63, wr = wid >> 2, wc = wid & 3, fr = lane & 15, fq = lane >> 4;
    const int K = g.K, nt = K / BK;
    unsigned voffA[2], voffB[2];
#pragma unroll
    for (int i = 0; i < 2; ++i) { int R, C; stage_rc(tid * 16 + i * 8192, R, C); const int Rb = Epi::PERM ? ((R & ~31) + perm32(R & 31)) : R;
        voffA[i] = (unsigned)(R * K + C) * 2u; voffB[i] = (unsigned)(Rb * K + C) * 2u; }
    const size_t kstep = (size_t)(BK * 2);
    const size_t hstep = (size_t)HALF * K * 2;
    const size_t tstep = 2 * hstep;
    const unsigned ldsw = (unsigned)wid * 1024u;
    const int aoff = lds_byte(wr * 64 + fr, fq * 8), boff = lds_byte(wc * 32 + fr, fq * 8);
#define PG8_SA(b, h) (((b) * 2 + (h)) * HTB)
#define PG8_SB(b, h) ((4 + (b) * 2 + (h)) * HTB)
#define PG8_STAGE(bufoff, gbase, voff) do { _Pragma("unroll") for (int _i = 0; _i < 2; ++_i) \
        __builtin_amdgcn_global_load_lds((const unsigned*)((const char*)(gbase) + (voff)[_i]), (PG8_LAS unsigned*)(lds + (bufoff) + ldsw + _i * 8192), 16, 0, 0); } while (0)
#define PG8_LDA(dst, b, h) do { _Pragma("unroll") for (int m = 0; m < 4; ++m) _Pragma("unroll") for (int k = 0; k < 2; ++k) dst[m][k] = *(const PG8_LAS bf16x8*)(lds + PG8_SA(b, h) + aoff + m * 2048 + k * 1024); } while (0)
#define PG8_LDB(dst, b, h) do { _Pragma("unroll") for (int n = 0; n < 2; ++n) _Pragma("unroll") for (int k = 0; k < 2; ++k) dst[n][k] = *(const PG8_LAS bf16x8*)(lds + PG8_SB(b, h) + boff + n * 2048 + k * 1024); } while (0)
#define PG8_MMA(ai, bj, At, Bt) do { __builtin_amdgcn_s_setprio(1); _Pragma("unroll") for (int m = 0; m < 4; ++m) _Pragma("unroll") for (int n = 0; n < 2; ++n) _Pragma("unroll") for (int k = 0; k < 2; ++k) \
        acc[ai][bj][m][n] = __builtin_amdgcn_mfma_f32_16x16x32_bf16(Bt[n][k], At[m][k], acc[ai][bj][m][n], 0, 0, 0); __builtin_amdgcn_s_setprio(0); } while (0)
#define PG8_WAIT_V(n) asm volatile("s_waitcnt vmcnt(" #n ")" ::: "memory")
#define PG8_WAIT_L(n) asm volatile("s_waitcnt lgkmcnt(" #n ")" ::: "memory")
#define PG8_BAR __builtin_amdgcn_s_barrier()
#define PG8_SCHED __builtin_amdgcn_sched_barrier(0)
    Unit cur, nxt; int ui = 0;
    if (!S.next(0, cur)) return;
    f32x4 acc[2][2][4][2];
#pragma unroll
    for (int a = 0; a < 2; ++a)
#pragma unroll
        for (int b = 0; b < 2; ++b)
#pragma unroll
            for (int m = 0; m < 4; ++m)
#pragma unroll
                for (int n = 0; n < 2; ++n) acc[a][b][m][n] = (f32x4){0.f, 0.f, 0.f, 0.f};
    bf16x8 At[4][2], B0[2][2], B1[2][2];
    const char* cA = (const char*)g.A + (size_t)cur.pm * tstep; const char* cB = (const char*)g.Bt + (size_t)cur.pn * tstep;
    S.a_ready(cur);
    if constexpr (SP2) {
        PG8_STAGE(PG8_SB(0, 0), cB, voffB); PG8_STAGE(PG8_SB(0, 1), cB + hstep, voffB); PG8_STAGE(PG8_SA(0, 0), cA, voffA); PG8_STAGE(PG8_SA(0, 1), cA + hstep, voffA);
        if (wr == 1) PG8_BAR;
        PG8_WAIT_V(2); PG8_BAR;
        PG8_STAGE(PG8_SB(1, 0), cB + kstep, voffB); PG8_STAGE(PG8_SA(1, 0), cA + kstep, voffA); PG8_STAGE(PG8_SB(1, 1), cB + hstep + kstep, voffB);
        PG8_WAIT_V(6); PG8_BAR;
    } else {
        PG8_STAGE(PG8_SB(0, 0), cB, voffB); PG8_STAGE(PG8_SA(0, 0), cA, voffA); PG8_STAGE(PG8_SB(0, 1), cB + hstep, voffB); PG8_STAGE(PG8_SA(0, 1), cA + hstep, voffA);
        if (wr == 1) PG8_BAR;
        PG8_WAIT_V(4); PG8_BAR;
        PG8_STAGE(PG8_SB(1, 0), cB + kstep, voffB); PG8_STAGE(PG8_SA(1, 0), cA + kstep, voffA); PG8_STAGE(PG8_SB(1, 1), cB + hstep + kstep, voffB);
        PG8_WAIT_V(6); PG8_BAR;
    }
    for (;;) {
        const bool has_next = S.next(ui + 1, nxt);
        const char* nA = has_next ? (const char*)g.A + (size_t)nxt.pm * tstep : cA; const char* nB = has_next ? (const char*)g.Bt + (size_t)nxt.pn * tstep : cB;
        for (int t = 0; t < nt; t += 2) {
            const bool last = (t == nt - 2);
            const char* a1 = cA + (size_t)(t + 1) * kstep;
            const char* a2 = last ? nA : cA + (size_t)(t + 2) * kstep; const char* b2 = last ? nB : cB + (size_t)(t + 2) * kstep;
            const char* a3 = a2 + kstep; const char* b3 = b2 + kstep;
            if (last && has_next) S.a_ready(nxt);
            if constexpr (SP2) {
            PG8_LDB(B0, 0, 0); PG8_LDB(B1, 0, 1); PG8_SCHED; PG8_LDA(At, 0, 0); PG8_STAGE(PG8_SA(1, 1), a1 + hstep, voffA);
            PG8_WAIT_V(8); PG8_WAIT_L(0); PG8_BAR; PG8_MMA(0, 0, At, B0); PG8_MMA(0, 1, At, B1); PG8_BAR; PG8_SCHED;
            PG8_LDA(At, 0, 1); PG8_STAGE(PG8_SB(0, 0), b2, voffB); PG8_STAGE(PG8_SB(0, 1), b2 + hstep, voffB); PG8_STAGE(PG8_SA(0, 0), a2, voffA);
            PG8_WAIT_V(8); PG8_WAIT_L(0); PG8_BAR; PG8_MMA(1, 0, At, B0); PG8_MMA(1, 1, At, B1); PG8_BAR; PG8_SCHED;
            PG8_LDB(B0, 1, 0); PG8_LDB(B1, 1, 1); PG8_SCHED; PG8_LDA(At, 1, 0); PG8_STAGE(PG8_SA(0, 1), a2 + hstep, voffA);
            PG8_WAIT_V(8); PG8_WAIT_L(0); PG8_BAR; PG8_MMA(0, 0, At, B0); PG8_MMA(0, 1, At, B1); PG8_BAR; PG8_SCHED;
            PG8_LDA(At, 1, 1); PG8_STAGE(PG8_SB(1, 0), b3, voffB); PG8_STAGE(PG8_SB(1, 1), b3 + hstep, voffB); PG8_STAGE(PG8_SA(1, 0), a3, voffA);
            PG8_WAIT_V(8); PG8_WAIT_L(0); PG8_BAR; PG8_MMA(1, 0, At, B0); PG8_MMA(1, 1, At, B1); PG8_BAR; PG8_SCHED;
            } else {
            PG8_LDB(B0, 0, 0); PG8_SCHED; PG8_LDA(At, 0, 0); PG8_STAGE(PG8_SA(1, 1), a1 + hstep, voffA);
            PG8_WAIT_L(8); PG8_BAR; PG8_WAIT_L(0); PG8_MMA(0, 0, At, B0); PG8_BAR; PG8_SCHED;
            PG8_LDB(B1, 0, 1); PG8_STAGE(PG8_SB(0, 0), b2, voffB);
            PG8_BAR; PG8_WAIT_L(0); PG8_MMA(0, 1, At, B1); PG8_BAR;
            PG8_LDA(At, 0, 1); PG8_STAGE(PG8_SA(0, 0), a2, voffA);
            PG8_BAR; PG8_WAIT_L(0); PG8_MMA(1, 0, At, B0); PG8_BAR; PG8_SCHED;
            PG8_STAGE(PG8_SB(0, 1), b2 + hstep, voffB);
            PG8_WAIT_V(6); PG8_BAR; PG8_MMA(1, 1, At, B1); PG8_BAR;
            PG8_LDB(B0, 1, 0); PG8_SCHED; PG8_LDA(At, 1, 0); PG8_STAGE(PG8_SA(0, 1), a2 + hstep, voffA);
            PG8_WAIT_L(8); PG8_BAR; PG8_WAIT_L(0); PG8_MMA(0, 0, At, B0); PG8_BAR; PG8_SCHED;
            PG8_LDB(B1, 1, 1); PG8_STAGE(PG8_SB(1, 0), b3, voffB);
            PG8_BAR; PG8_WAIT_L(0); PG8_MMA(0, 1, At, B1); PG8_BAR;
            PG8_LDA(At, 1, 1); PG8_STAGE(PG8_SA(1, 0), a3, voffA);
            PG8_BAR; PG8_WAIT_L(0); PG8_MMA(1, 0, At, B0); PG8_BAR; PG8_SCHED;
            PG8_STAGE(PG8_SB(1, 1), b3 + hstep, voffB);
            PG8_WAIT_V(6); PG8_BAR; PG8_MMA(1, 1, At, B1); PG8_BAR;
            }
        }
        if constexpr (ALIGN_EPI) { if (wr == 0) PG8_BAR; }
        if constexpr (!Epi::AFTER_DRAIN) { E(acc, cur, wr, wc, fr, fq); S.done(cur); }
        if (!has_next) break;
#pragma unroll
        for (int a = 0; a < 2; ++a)
#pragma unroll
            for (int b = 0; b < 2; ++b)
#pragma unroll
                for (int m = 0; m < 4; ++m)
#pragma unroll
                    for (int n = 0; n < 2; ++n) acc[a][b][m][n] = (f32x4){0.f, 0.f, 0.f, 0.f};
        cur = nxt; cA = nA; cB = nB; ++ui;
        if constexpr (ALIGN_EPI) { if (wr == 1) PG8_BAR; }
    }
    PG8_WAIT_V(0);
    if constexpr (!ALIGN_EPI) { if (wr == 0) PG8_BAR; }
    PG8_BAR;
    if constexpr (Epi::AFTER_DRAIN) { E.fused(acc, cur, wr, wc, fr, fq, lds, wid, lane); S.done(cur); }
#undef PG8_SA
#undef PG8_SB
#undef PG8_STAGE
#undef PG8_LDA
#undef PG8_LDB
#undef PG8_MMA
#undef PG8_WAIT_V
#undef PG8_WAIT_L
#undef PG8_BAR
#undef PG8_SCHED
}
}
namespace wsmap {
constexpr int S = 8192, FF = 5632;
constexpr size_t MiB = 1u << 20;
constexpr size_t WS_CTL = 0, CTL_ZERO_BYTES = 1 * MiB;
constexpr size_t WS_COS = 1 * MiB, WS_SIN = WS_COS + 512 * 1024, WS_LB = 2 * MiB, WS_LAM = WS_LB + 16384;
constexpr size_t WS_W = 4 * MiB, W_LAYER = 126 * MiB;
constexpr size_t WO_IN = 0, WO_A = 44 * MiB, WO_B = 48 * MiB, WO_OUT = 52 * MiB, WO_FI = 60 * MiB, WO_FO = 104 * MiB;
constexpr size_t WS_H = 508 * MiB, WS_QH = 540 * MiB, WS_KK = 556 * MiB, WS_LOGF = 572 * MiB, WS_VH = 604 * MiB, WS_GH = 620 * MiB, WS_DQ = 636 * MiB, WS_DK = 652 * MiB, WS_DV = 668 * MiB,
                 WS_GA = 684 * MiB, WS_GB = 716 * MiB, WS_HLOC = 748 * MiB, WS_ST = 812 * MiB, WS_DEC = 844 * MiB, WS_AO = 846 * MiB, WS_OA = 878 * MiB, WS_OB = 894 * MiB, WS_MERGED = 910 * MiB,
                 WS_Y = 942 * MiB, WS_END = 1006 * MiB;
constexpr size_t WS_ACT = 540 * MiB;
static_assert(WS_ACT + (size_t)S * FF * 2 <= WS_DQ, "act overlay");
}
namespace pg8 {
__device__ __forceinline__ float fsig(float x) { return __builtin_amdgcn_rcpf(1.f + __expf(-x)); }
__device__ __forceinline__ float fsilu(float x) { return x * fsig(x); }
__device__ __forceinline__ float bf_lo(unsigned w) { return __uint_as_float(w << 16); }
__device__ __forceinline__ float bf_hi(unsigned w) { return __uint_as_float(w & 0xffff0000u); }
__device__ __forceinline__ u32x4 pack8bf(const f32x4& v0, const f32x4& v1) { u32x4 w; w.x = cvt_pk_bf16(v0[0], v0[1]); w.y = cvt_pk_bf16(v0[2], v0[3]); w.z = cvt_pk_bf16(v1[0], v1[1]); w.w = cvt_pk_bf16(v1[2], v1[3]); return w; }

struct EpiF32 {
    static constexpr bool PERM = false, AFTER_DRAIN = false;
    float* C; int ldc;
    __device__ __forceinline__ void operator()(const f32x4 (&acc)[2][2][4][2], const Unit& u, int wr, int wc, int fr, int fq) const {
        const int row0 = u.pm * BM + wr * 64 + fr, col0 = u.pn * BM + wc * 32 + 4 * fq;
#pragma unroll
        for (int ai = 0; ai < 2; ++ai)
#pragma unroll
            for (int m = 0; m < 4; ++m) { float* rowp = C + (size_t)(row0 + ai * HALF + m * 16) * ldc + col0;
#pragma unroll
                for (int bj = 0; bj < 2; ++bj)
#pragma unroll
                    for (int n = 0; n < 2; ++n) *(f32x4*)(rowp + bj * HALF + n * 16) = acc[ai][bj][m][n]; }
    }
};
struct EpiIn {
    static constexpr bool PERM = true, AFTER_DRAIN = false;
    unsigned char* ws; const float* lb;
    __device__ __forceinline__ void operator()(const f32x4 (&acc)[2][2][4][2], const Unit& u, int wr, int wc, int fr, int fq) const {
        using namespace wsmap;
        const int row0 = u.pm * BM + wr * 64 + fr, pn = u.pn, cw = wc * 32 + 8 * fq;
        bf16_t* KK = (bf16_t*)(ws + WS_KK); float* LOGF = (float*)(ws + WS_LOGF); const float* cosT = (const float*)(ws + WS_COS); const float* sinT = (const float*)(ws + WS_SIN);
        if (pn < 16) {
            const int sec = pn >> 2, cs0 = (pn & 3) * 256 + cw;
            if (sec == 1) {
                f32x4 lbv[2][2];
#pragma unroll
                for (int bj = 0; bj < 2; ++bj)
#pragma unroll
                    for (int n = 0; n < 2; ++n) lbv[bj][n] = *(const f32x4*)(lb + cs0 + bj * HALF + 4 * n);
#pragma unroll
                for (int ai = 0; ai < 2; ++ai)
#pragma unroll
                    for (int m = 0; m < 4; ++m) { const size_t ro = (size_t)(row0 + ai * HALF + m * 16) * 1024 + cs0;
#pragma unroll
                        for (int bj = 0; bj < 2; ++bj) { f32x4 kv[2], lv[2];
#pragma unroll
                            for (int n = 0; n < 2; ++n)
#pragma unroll
                                for (int j = 0; j < 4; ++j) { float x = acc[ai][bj][m][n][j]; x = fminf(fmaxf(x, -80.f), 80.f); const float l = lbv[bj][n][j];
                                    const float e = __expf(-fabsf(x)), inv = __builtin_amdgcn_rcpf(1.f + e); const bool pos = x >= 0.f;
                                    const float nf = pos ? (1.f + l * e) : (e + l), nk = pos ? e : 1.f;
                                    kv[n][j] = (1.f - l) * nk * inv; lv[n][j] = __logf(nf * inv); }
                            *(u32x4*)(KK + ro + bj * HALF) = pack8bf(kv[0], kv[1]);
                            *(f32x4*)(LOGF + ro + bj * HALF) = lv[0]; *(f32x4*)(LOGF + ro + bj * HALF + 4) = lv[1]; } }
            } else {
                bf16_t* dst = (bf16_t*)(ws + (sec == 0 ? WS_QH : (sec == 2 ? WS_VH : WS_GH)));
#pragma unroll
                for (int ai = 0; ai < 2; ++ai)
#pragma unroll
                    for (int m = 0; m < 4; ++m) { bf16_t* rowp = dst + (size_t)(row0 + ai * HALF + m * 16) * 1024 + cs0;
#pragma unroll
                        for (int bj = 0; bj < 2; ++bj) { f32x4 v0 = acc[ai][bj][m][0], v1 = acc[ai][bj][m][1];
                            if (sec != 2) {
#pragma unroll
                                for (int j = 0; j < 4; ++j) { v0[j] = fsilu(v0[j]); v1[j] = fsilu(v1[j]); } }
                            *(u32x4*)(rowp + bj * HALF) = pack8bf(v0, v1); } }
            }
        } else if (pn < 24) {
            bf16_t* base = (bf16_t*)(ws + (pn < 20 ? WS_DQ : WS_DK)) + (size_t)((pn & 3) * 2) * (8192 * 128);
            const float sg = (fq < 2) ? -1.f : 1.f; const int ti = 8 * (fq & 1);
#pragma unroll
            for (int ai = 0; ai < 2; ++ai)
#pragma unroll
                for (int m = 0; m < 4; ++m) { const int row = row0 + ai * HALF + m * 16;
                    f32x4 c0, c1, s0, s1;
                    if (wc == 0) { c0 = *(const f32x4*)(cosT + row * 16 + ti); c1 = *(const f32x4*)(cosT + row * 16 + ti + 4); s0 = *(const f32x4*)(sinT + row * 16 + ti); s1 = *(const f32x4*)(sinT + row * 16 + ti + 4); }
#pragma unroll
                    for (int bj = 0; bj < 2; ++bj) { f32x4 v0 = acc[ai][bj][m][0], v1 = acc[ai][bj][m][1];
                        if (wc == 0) {
#pragma unroll
                            for (int j = 0; j < 4; ++j) { const float o0 = __shfl_xor(v0[j], 32), o1 = __shfl_xor(v1[j], 32);
                                v0[j] = v0[j] * c0[j] + sg * o0 * s0[j]; v1[j] = v1[j] * c1[j] + sg * o1 * s1[j]; } }
                        *(u32x4*)(base + (size_t)bj * (8192 * 128) + (size_t)row * 128 + cw) = pack8bf(v0, v1); } }
        } else if (pn < 28) {
            bf16_t* base = (bf16_t*)(ws + WS_DV) + (size_t)((pn & 3) * 2) * (8192 * 128);
#pragma unroll
            for (int ai = 0; ai < 2; ++ai)
#pragma unroll
                for (int m = 0; m < 4; ++m) { const int row = row0 + ai * HALF + m * 16;
#pragma unroll
                    for (int bj = 0; bj < 2; ++bj) *(u32x4*)(base + (size_t)bj * (8192 * 128) + (size_t)row * 128 + cw) = pack8bf(acc[ai][bj][m][0], acc[ai][bj][m][1]); }
        } else {
            bf16_t* dst = (bf16_t*)(ws + (pn < 36 ? WS_GA : WS_GB)); const int cs0 = ((pn - 28) & 7) * 256 + cw;
#pragma unroll
            for (int ai = 0; ai < 2; ++ai)
#pragma unroll
                for (int m = 0; m < 4; ++m) { bf16_t* rowp = dst + (size_t)(row0 + ai * HALF + m * 16) * 2048 + cs0;
#pragma unroll
                    for (int bj = 0; bj < 2; ++bj) { f32x4 v0 = acc[ai][bj][m][0], v1 = acc[ai][bj][m][1];
#pragma unroll
                        for (int j = 0; j < 4; ++j) { v0[j] = fsig(v0[j]); v1[j] = fsig(v1[j]); }
                        *(u32x4*)(rowp + bj * HALF) = pack8bf(v0, v1); } }
        }
    }
};
struct EpiSwiglu {
    static constexpr bool PERM = true, AFTER_DRAIN = false;
    bf16_t* ACT;
    __device__ __forceinline__ void operator()(const f32x4 (&acc)[2][2][4][2], const Unit& u, int wr, int wc, int fr, int fq) const {
        const int row0 = u.pm * BM + wr * 64 + fr, col0 = u.pn * HALF + wc * 32 + 8 * fq;
#pragma unroll
        for (int ai = 0; ai < 2; ++ai)
#pragma unroll
            for (int m = 0; m < 4; ++m) { f32x4 v0, v1;
#pragma unroll
                for (int j = 0; j < 4; ++j) { v0[j] = fsilu(acc[ai][0][m][0][j]) * acc[ai][1][m][0][j]; v1[j] = fsilu(acc[ai][0][m][1][j]) * acc[ai][1][m][1][j]; }
                *(u32x4*)(ACT + (size_t)(row0 + ai * HALF + m * 16) * 5632 + col0) = pack8bf(v0, v1); }
    }
};
struct EpiGate1 {
    static constexpr bool PERM = true, AFTER_DRAIN = false;
    float* T; const bf16_t* G;
    __device__ __forceinline__ void operator()(const f32x4 (&acc)[2][2][4][2], const Unit& u, int wr, int wc, int fr, int fq) const {
        const int row0 = u.pm * BM + wr * 64 + fr, col0 = u.pn * BM + wc * 32 + 8 * fq;
#pragma unroll
        for (int ai = 0; ai < 2; ++ai)
#pragma unroll
            for (int m = 0; m < 4; ++m) { const size_t ro = (size_t)(row0 + ai * HALF + m * 16) * 2048 + col0;
#pragma unroll
                for (int bj = 0; bj < 2; ++bj) { const u32x4 g = *(const u32x4*)(G + ro + bj * HALF); const f32x4 a0 = acc[ai][bj][m][0], a1 = acc[ai][bj][m][1];
                    *(f32x4*)(T + ro + bj * HALF) = (f32x4){a0[0] * bf_lo(g.x), a0[1] * bf_hi(g.x), a0[2] * bf_lo(g.y), a0[3] * bf_hi(g.y)};
                    *(f32x4*)(T + ro + bj * HALF + 4) = (f32x4){a1[0] * bf_lo(g.z), a1[1] * bf_hi(g.z), a1[2] * bf_lo(g.w), a1[3] * bf_hi(g.w)}; } }
    }
};
struct EpiGate2 {
    static constexpr bool PERM = true, AFTER_DRAIN = false;
    const float* T; const bf16_t* G; bf16_t* O;
    __device__ __forceinline__ void operator()(const f32x4 (&acc)[2][2][4][2], const Unit& u, int wr, int wc, int fr, int fq) const {
        const int row0 = u.pm * BM + wr * 64 + fr, col0 = u.pn * BM + wc * 32 + 8 * fq;
#pragma unroll
        for (int ai = 0; ai < 2; ++ai)
#pragma unroll
            for (int m = 0; m < 4; ++m) { const size_t ro = (size_t)(row0 + ai * HALF + m * 16) * 2048 + col0;
#pragma unroll
                for (int bj = 0; bj < 2; ++bj) { const u32x4 g = *(const u32x4*)(G + ro + bj * HALF); const f32x4 a0 = acc[ai][bj][m][0], a1 = acc[ai][bj][m][1];
                    const f32x4 t0 = *(const f32x4*)(T + ro + bj * HALF), t1 = *(const f32x4*)(T + ro + bj * HALF + 4);
                    const f32x4 v0 = {t0[0] + a0[0] * bf_lo(g.x), t0[1] + a0[1] * bf_hi(g.x), t0[2] + a0[2] * bf_lo(g.y), t0[3] + a0[3] * bf_hi(g.y)};
                    const f32x4 v1 = {t1[0] + a1[0] * bf_lo(g.z), t1[1] + a1[1] * bf_hi(g.z), t1[2] + a1[2] * bf_lo(g.w), t1[3] + a1[3] * bf_hi(g.w)};
                    *(u32x4*)(O + ro + bj * HALF) = pack8bf(v0, v1); } }
    }
};
}
namespace att {
constexpr int D = 128;
constexpr float THR = 8.f;
constexpr bool WSKIP = false;
constexpr float SCALE = 0.08838834764831845f;
constexpr int NW = 8, QBLK = 32, KVBLK = 64, QB = NW * QBLK;
constexpr int SHM_V = KVBLK * D * 2, SHM_K = KVBLK * D * 2;
constexpr int LDS_BYTES = 2 * SHM_V + 2 * SHM_K + NW * 64 * 4;
using bf16 = __hip_bfloat16;
typedef short bf16x8 __attribute__((ext_vector_type(8)));
typedef short s16x4 __attribute__((ext_vector_type(4)));
typedef float f32x16 __attribute__((ext_vector_type(16)));
typedef float f32x4 __attribute__((ext_vector_type(4)));
typedef unsigned u32x4 __attribute__((ext_vector_type(4)));
template <class A, class Bt> struct same_t { static constexpr bool v = false; };
template <class A> struct same_t<A, A> { static constexpr bool v = true; };

#define KSWZ(row, colB) ((row) * 256 + ((colB) ^ (((row) & 7) << 4)))
#define SBAR() __builtin_amdgcn_sched_barrier(0)
__device__ __forceinline__ int v_st(int k, int c) { const int kk = (k & ~0xC) | ((k & 4) << 1) | ((k & 8) >> 1); return ((kk >> 3) * 4 + (c >> 5)) * 512 + ((kk & 7) * 32 + (c & 31)) * 2; }
__device__ __forceinline__ int v_rd_base(int lane) { return ((lane & 3) << 3) | (((lane >> 2) & 3) << 6) | (((lane >> 4) & 1) << 5) | (((lane >> 5) & 1) << 8); }
constexpr int v_rd_off(int d0, int ks, int half) { return d0 * 512 + ks * 4096 + half * 2048; }
__device__ __forceinline__ int crow(int r, int hi) { return (r & 3) + 8 * (r >> 2) + 4 * hi; }
__device__ __forceinline__ unsigned cvtpk(float lo, float hi) {
    unsigned r; asm volatile("v_cvt_pk_bf16_f32 %0, %1, %2" : "=v"(r) : "v"(lo), "v"(hi)); return r;
}
__device__ __forceinline__ bf16x8 pack8(f32x4 a, f32x4 b) {
    u32x4 w = {cvtpk(a[0], a[1]), cvtpk(a[2], a[3]), cvtpk(b[0], b[1]), cvtpk(b[2], b[3])};
    return *reinterpret_cast<bf16x8*>(&w);
}
template <class T> __device__ __forceinline__ bf16x8 load8(const T* p) {
    if constexpr (same_t<T, float>::v) { return pack8(*(const f32x4*)p, *(const f32x4*)(p + 4)); }
    else { return *reinterpret_cast<const bf16x8*>(p); }
}
__device__ __forceinline__ void mask_tile(f32x16& p0, f32x16& p1, int dq, unsigned W) {
    const float NEG = -__builtin_inff();
#pragma unroll
    for (int r = 0; r < 16; ++r) {
        const int c = (r & 3) + 8 * (r >> 2);
        if ((unsigned)(dq - c) >= W) p0[r] = NEG;
        if ((unsigned)(dq - c - 32) >= W) p1[r] = NEG;
    }
}
__device__ __forceinline__ void partialSM(f32x16& p0, f32x16& p1, float& m_reg, float& mn, float& alpha) {
    float pmax = p0[0]; for (int r = 1; r < 16; ++r) pmax = fmaxf(pmax, p0[r]); for (int r = 0; r < 16; ++r) pmax = fmaxf(pmax, p1[r]);
    { auto rr = __builtin_amdgcn_permlane32_swap(__float_as_uint(pmax), __float_as_uint(pmax), false, false);
      pmax = fmaxf(__uint_as_float(rr[0]), __uint_as_float(rr[1])); }
    constexpr float C2 = 1.4426950408889634f * SCALE;
    if (__builtin_expect(__all((pmax - m_reg) * SCALE <= THR), 1)) { mn = m_reg; alpha = 1.f; }
    else { mn = fmaxf(m_reg, pmax); alpha = __builtin_amdgcn_exp2f((m_reg - mn) * C2); m_reg = mn; }
    const float mnL = -mn * C2;
    for (int r = 0; r < 16; ++r) p0[r] = fmaf(p0[r], C2, mnL); for (int r = 0; r < 16; ++r) p1[r] = fmaf(p1[r], C2, mnL);
    for (int r = 0; r < 16; ++r) p0[r] = __builtin_amdgcn_exp2f(p0[r]);
}
__device__ __forceinline__ void finishSM(f32x16& p0, f32x16& p1, float alpha, float& l_reg, bf16x8& pa0, bf16x8& pa1, bf16x8& pa2, bf16x8& pa3) {
    for (int r = 0; r < 16; ++r) p1[r] = __builtin_amdgcn_exp2f(p1[r]);
    float ps = 0; for (int r = 0; r < 16; ++r) ps += p0[r]; for (int r = 0; r < 16; ++r) ps += p1[r];
    { auto rr = __builtin_amdgcn_permlane32_swap(__float_as_uint(ps), __float_as_uint(ps), false, false);
      ps = __uint_as_float(rr[0]) + __uint_as_float(rr[1]); }
    l_reg = l_reg * alpha + ps;
#define PK4(P, B_, OUT) do { unsigned a0 = cvtpk(P[B_+0], P[B_+1]), a1 = cvtpk(P[B_+2], P[B_+3]);                          \
        unsigned b0 = cvtpk(P[B_+4], P[B_+5]), b1 = cvtpk(P[B_+6], P[B_+7]);                                             \
        auto r0 = __builtin_amdgcn_permlane32_swap(a0, b0, false, false); auto r1 = __builtin_amdgcn_permlane32_swap(a1, b1, false, false); \
        u32x4 w = {r0[0], r1[0], r0[1], r1[1]}; OUT = *reinterpret_cast<bf16x8*>(&w); } while (0)
    PK4(p0, 0, pa0); PK4(p0, 8, pa1); PK4(p1, 0, pa2); PK4(p1, 8, pa3);
#undef PK4
}
template <int KB, bool SK>
__device__ __forceinline__ void qkt(f32x16& p0, f32x16& p1, const char* K_lds, int r32, int hi, const bf16x8* qr, bool act) {
    if (SK && !act) { const float NEG = -__builtin_inff();
#pragma unroll
        for (int r = 0; r < 16; ++r) { p0[r] = NEG; p1[r] = NEG; } return; }
    p0 = f32x16{}; p1 = f32x16{};
    const char* kb[4];
#pragma unroll
    for (int dd = 0; dd < 4; ++dd) kb[dd] = K_lds + KB * SHM_K + KSWZ(r32, (dd * 16 + hi * 8) * 2);
#pragma unroll
    for (int d0 = 0; d0 < 8; ++d0) { const char* a = kb[d0 & 3] + (d0 >> 2) * 128;
        bf16x8 b0 = *reinterpret_cast<const bf16x8*>(a);
        bf16x8 b1 = *reinterpret_cast<const bf16x8*>(a + 32 * 256);
        p0 = __builtin_amdgcn_mfma_f32_32x32x16_bf16(b0, qr[d0], p0, 0, 0, 0);
        p1 = __builtin_amdgcn_mfma_f32_32x32x16_bf16(b1, qr[d0], p1, 0, 0, 0); }
}
template <int VB, bool SK>
__device__ __forceinline__ void pv_tile(f32x16* o, int vb0, bf16x8 pa0, bf16x8 pa1, bf16x8 pa2, bf16x8 pa3, bool act) {
    if (SK && !act) return;
#define TRRD(dst, off) asm volatile("ds_read_b64_tr_b16 %0, %1 offset:%2" : "=&v"(dst) : "v"(vb0), "i"(off) : "memory")
#define PV_D0(d0) do { s16x4 l0, l1, l2, l3, h0, h1, h2, h3; constexpr int b_ = VB * SHM_V + v_rd_off(d0, 0, 0);     \
        TRRD(l0, b_); TRRD(h0, b_ + 2048); TRRD(l1, b_ + 4096); TRRD(h1, b_ + 6144); TRRD(l2, b_ + 8192); TRRD(h2, b_ + 10240); TRRD(l3, b_ + 12288); TRRD(h3, b_ + 14336); \
        asm volatile("s_waitcnt lgkmcnt(0)" ::: "memory"); SBAR();                 \
        o[d0] = __builtin_amdgcn_mfma_f32_32x32x16_bf16(pa0, (bf16x8){l0[0], l0[1], l0[2], l0[3], h0[0], h0[1], h0[2], h0[3]}, o[d0], 0, 0, 0);   \
        o[d0] = __builtin_amdgcn_mfma_f32_32x32x16_bf16(pa1, (bf16x8){l1[0], l1[1], l1[2], l1[3], h1[0], h1[1], h1[2], h1[3]}, o[d0], 0, 0, 0);   \
        o[d0] = __builtin_amdgcn_mfma_f32_32x32x16_bf16(pa2, (bf16x8){l2[0], l2[1], l2[2], l2[3], h2[0], h2[1], h2[2], h2[3]}, o[d0], 0, 0, 0);   \
        o[d0] = __builtin_amdgcn_mfma_f32_32x32x16_bf16(pa3, (bf16x8){l3[0], l3[1], l3[2], l3[3], h3[0], h3[1], h3[2], h3[3]}, o[d0], 0, 0, 0); } while (0)
    PV_D0(0); PV_D0(1); PV_D0(2); PV_D0(3);
#undef PV_D0
#undef TRRD
}

template <class TIn, class TOut> struct BlockRef { const TIn* Q; const TIn* K; const TIn* V; TOut* O; int P0; };
template <class TIn> struct Seam {
    bf16x8 qr[8];
    bf16x8 st_v0, st_v1, st_k0, st_k1; f32x4 sf0, sf1, sf2, sf3;
    f32x4 tq[16];
};
__device__ __forceinline__ int swa_jlo(int P0, int W) { const int lowk = P0 - W + 1; return lowk > 0 ? lowk / KVBLK : 0; }
#define ROW(p, k0, rr) ((p) + (size_t)((k0) + (rr)) * D + sc)
#define VMW() asm volatile("s_waitcnt vmcnt(0)" ::: "memory")
#define VMWN(n) asm volatile("s_waitcnt vmcnt(%0)" :: "i"(n) : "memory")
#define SLOAD_H(Kp, Vp, k0) do { S.st_v0 = load8<TIn>(ROW(Vp, k0, sr)); S.st_v1 = load8<TIn>(ROW(Vp, k0, 32 + sr));              \
                         S.st_k0 = load8<TIn>(ROW(Kp, k0, sr)); S.st_k1 = load8<TIn>(ROW(Kp, k0, 32 + sr)); } while (0)
#define SWRITE_HK(bf) do { *(bf16x8*)(K_lds + (bf) * SHM_K + kws) = S.st_k0; *(bf16x8*)(K_lds + (bf) * SHM_K + kws + 32 * 256) = S.st_k1; } while (0)
#define SWRITE_HV(bf) do { *(bf16x8*)(V_lds + (bf) * SHM_V + vst0) = S.st_v0; *(bf16x8*)(V_lds + (bf) * SHM_V + vst1) = S.st_v1; } while (0)
#define SWRITE_H(bf) do { SWRITE_HV(bf); SWRITE_HK(bf); } while (0)
#define SLOAD_F(p, k0) do { S.sf0 = *(const f32x4*)ROW(p, k0, sr); S.sf1 = *(const f32x4*)(ROW(p, k0, sr) + 4);                \
                            S.sf2 = *(const f32x4*)ROW(p, k0, 32 + sr); S.sf3 = *(const f32x4*)(ROW(p, k0, 32 + sr) + 4); } while (0)
#define SWRITE_KF(bf) do { *(bf16x8*)(K_lds + (bf) * SHM_K + kws) = pack8(S.sf0, S.sf1); *(bf16x8*)(K_lds + (bf) * SHM_K + kws + 32 * 256) = pack8(S.sf2, S.sf3); } while (0)
#define SWRITE_VF(bf) do { *(bf16x8*)(V_lds + (bf) * SHM_V + vst0) = pack8(S.sf0, S.sf1); *(bf16x8*)(V_lds + (bf) * SHM_V + vst1) = pack8(S.sf2, S.sf3); } while (0)
template <class TIn, class TOut>
__device__ __forceinline__ void causal_swa_prime(const BlockRef<TIn, TOut>& cur, int W, char* lds, Seam<TIn>& S) {
    constexpr bool F32 = same_t<TIn, float>::v;
    int tid_o = threadIdx.x; asm volatile("" : "+v"(tid_o));
    const int tid = tid_o, wid = __builtin_amdgcn_readfirstlane(tid >> 6), lane = tid & 63, r32 = lane & 31, hi = lane >> 5;
    const int sr = tid >> 4, sc = (tid & 15) * 8, kws = KSWZ(sr, sc * 2); char* K_lds = lds + 2 * SHM_V;
    const int kb0 = swa_jlo(cur.P0, W) * KVBLK;
    for (int d0 = 0; d0 < 8; ++d0) S.qr[d0] = load8<TIn>(cur.Q + (size_t)(wid * QBLK + r32) * D + d0 * 16 + hi * 8);
    if constexpr (F32) { SLOAD_F((const float*)cur.K, kb0); VMW(); SWRITE_KF(0); SBAR(); SLOAD_F((const float*)cur.V, kb0); }
    else { SLOAD_H(cur.K, cur.V, kb0); VMW(); SWRITE_HK(0); }
    __syncthreads();
}
template <class TIn, class TOut>
__device__ __forceinline__ void causal_swa_block(const BlockRef<TIn, TOut>& cur, const BlockRef<TIn, TOut>& nxt, int skv, int W, char* lds, Seam<TIn>& S) {
    constexpr bool F32 = same_t<TIn, float>::v;
    int tid_o = threadIdx.x; asm volatile("" : "+v"(tid_o));
    const int tid = tid_o, wid = __builtin_amdgcn_readfirstlane(tid >> 6), lane = tid & 63, r32 = lane & 31, hi = lane >> 5;
    const int j_lo = swa_jlo(cur.P0, W);
    int j_hi = (cur.P0 + QB - 1) / KVBLK + 1; if (j_hi > skv / KVBLK) j_hi = skv / KVBLK;
    const int NT = j_hi - j_lo;
    const int kbn = swa_jlo(nxt.P0, W) * KVBLK;
    const int qlo = cur.P0 + wid * QBLK, pe = qlo | 63, qm = pe - 4 * hi;
    char* V_lds = lds; char* K_lds = lds + 2 * SHM_V;
    float* ws = (float*)(lds + 2 * SHM_V + 2 * SHM_K) + wid * 64; float* li_l = ws, * al_l = ws + 32;
    float m_reg = -1e30f, l_reg = 0; f32x16 o[4] = {};
    const int sr = tid >> 4, sc = (tid & 15) * 8, vst0 = v_st(sr, sc), vst1 = v_st(32 + sr, sc), kws = KSWZ(sr, sc * 2);
    const int vb0 = (int)(uintptr_t)V_lds + v_rd_base(lane);
    const TIn* Kh = cur.K; const TIn* Vh = cur.V;
#define RESC(a) do { if (__any((a) < 1.f)) { if (hi == 0) al_l[r32] = (a); asm volatile("s_waitcnt lgkmcnt(0)" ::: "memory");              \
                     for (int d_ = 0; d_ < 4; ++d_) for (int r = 0; r < 16; ++r) o[d_][r] *= al_l[crow(r, hi)]; } } while (0)
#define KBASE(t) ((j_lo + (t)) * KVBLK)
#define ACT(t) (KBASE(t) <= qlo + QBLK - 1 && KBASE(t) + KVBLK - 1 >= qlo - W + 1)
#define MASKT(P0_, P1_, t) do { const int kb_ = KBASE(t); if (kb_ > pe) mask_tile(P0_, P1_, qm - kb_, (unsigned)W); } while (0)
    constexpr int NQL = F32 ? 16 : 8;
    constexpr bool SK = WSKIP && !F32;
#define SEAM_K0() do { VMWN(NQL); if constexpr (F32) { SWRITE_KF(0); SBAR(); SLOAD_F((const float*)nxt.V, kbn); } else { SWRITE_HK(0); } SBAR(); } while (0)
    f32x16 pA0, pA1, pB0, pB1; float mnA, mnB, alA, alB; bf16x8 pa0, pa1, pa2, pa3;
    if constexpr (F32) { VMW(); SWRITE_VF(0); SBAR(); } else { SWRITE_HV(0); SBAR(); }
    if (NT > 1) { if constexpr (F32) SLOAD_F((const float*)Kh, KBASE(1)); else SLOAD_H(Kh, Vh, KBASE(1)); }
    SBAR(); qkt<0, SK>(pA0, pA1, K_lds, r32, hi, S.qr, ACT(0));
    if constexpr (F32) { if (NT > 1) { VMW(); SWRITE_KF(1); SBAR(); SLOAD_F((const float*)Vh, KBASE(1)); } }
    MASKT(pA0, pA1, 0); partialSM(pA0, pA1, m_reg, mnA, alA);
    if (NT > 1) { VMW(); if constexpr (F32) { SWRITE_VF(1); SBAR(); if (NT > 2) SLOAD_F((const float*)Kh, KBASE(2)); } else SWRITE_H(1); }
    __syncthreads();
#define HALF_STEP(PX0, PX1, mnX, alX, PY0, PY1, alY, t, KB, VB, SB) do {                                                      \
        SBAR(); qkt<KB, SK>(PX0, PX1, K_lds, r32, hi, S.qr, ACT(t));                                             \
        finishSM(PY0, PY1, alY, l_reg, pa0, pa1, pa2, pa3); SBAR();                                                           \
        if ((t) + 1 < NT) { if constexpr (F32) { VMW(); SWRITE_KF(SB); SBAR(); SLOAD_F((const float*)Vh, KBASE((t) + 1)); }  \
                            else { SLOAD_H(Kh, Vh, KBASE((t) + 1)); } SBAR(); }                                               \
        pv_tile<VB, SK>(o, vb0, pa0, pa1, pa2, pa3, ACT((t) - 1)); MASKT(PX0, PX1, (t)); partialSM(PX0, PX1, m_reg, mnX, alX);                                        \
        __syncthreads();                                                                                                      \
        if ((t) + 1 < NT) { VMW(); if constexpr (F32) { SWRITE_VF(SB); SBAR(); if ((t) + 2 < NT) SLOAD_F((const float*)Kh, KBASE((t) + 2)); } \
                            else { SWRITE_H(SB); } }                                                                          \
        RESC(alX); __syncthreads(); } while (0)
    for (int t = 1; t + 1 < NT; t += 2) {
        HALF_STEP(pB0, pB1, mnB, alB, pA0, pA1, alA, t, 1, 0, 0);
        HALF_STEP(pA0, pA1, mnA, alA, pB0, pB1, alB, t + 1, 0, 1, 1);
    }
    const bool even = (NT & 1) == 0;
    if (even) { SBAR(); qkt<1, SK>(pB0, pB1, K_lds, r32, hi, S.qr, ACT(NT - 1)); SBAR(); }
#define QROW(e) (nxt.Q + (size_t)(wid * QBLK + r32) * D + ((e) >> 1) * 16 + hi * 8 + ((e) & 1) * 4)
    if constexpr (F32) { SLOAD_F((const float*)nxt.K, kbn); SBAR();
#pragma unroll
        for (int e = 0; e < 8; ++e) S.tq[e] = *(const f32x4*)QROW(e); }
    else { SLOAD_H(nxt.K, nxt.V, kbn); SBAR();
#pragma unroll
        for (int d0 = 0; d0 < 8; ++d0) S.qr[d0] = load8<TIn>(nxt.Q + (size_t)(wid * QBLK + r32) * D + d0 * 16 + hi * 8); }
    SBAR();
    finishSM(pA0, pA1, alA, l_reg, pa0, pa1, pa2, pa3); SBAR();
    if constexpr (F32) {
#pragma unroll
        for (int e = 8; e < 16; ++e) S.tq[e] = *(const f32x4*)QROW(e); SBAR(); }
#undef QROW
    pv_tile<0, SK>(o, vb0, pa0, pa1, pa2, pa3, ACT(even ? NT - 2 : NT - 1));
    if (even) { MASKT(pB0, pB1, NT - 1); partialSM(pB0, pB1, m_reg, mnB, alB); __syncthreads(); RESC(alB);
        finishSM(pB0, pB1, alB, l_reg, pa0, pa1, pa2, pa3); SBAR(); pv_tile<1, SK>(o, vb0, pa0, pa1, pa2, pa3, ACT(NT - 1)); }
    SBAR(); SEAM_K0();
    if (hi == 0) li_l[r32] = l_reg; asm volatile("s_waitcnt lgkmcnt(0)" ::: "memory");
    float rli[16];
#pragma unroll
    for (int r = 0; r < 16; ++r) rli[r] = __builtin_amdgcn_rcpf(li_l[crow(r, hi)]);
    TOut* Ow = cur.O + (size_t)(wid * QBLK) * D;
#pragma unroll
    for (int r = 0; r < 16; ++r) { const int orow = crow(r, hi);
#pragma unroll
        for (int d0 = 0; d0 < 4; ++d0) { const float v = o[d0][r] * rli[r];
            if constexpr (same_t<TOut, float>::v) { Ow[(size_t)orow * D + d0 * 32 + r32] = v; }
            else { const float vn = __shfl_xor(v, 1);
                   if ((r32 & 1) == 0) *(unsigned*)(Ow + (size_t)orow * D + d0 * 32 + r32) = cvtpk(v, vn); } } }
    if constexpr (F32) {
#pragma unroll
        for (int d0 = 0; d0 < 8; ++d0) S.qr[d0] = pack8(S.tq[2 * d0], S.tq[2 * d0 + 1]); }
    __syncthreads();
#undef RESC
#undef KBASE
#undef ACT
#undef MASKT
#undef SEAM_K0
#undef HALF_STEP
}
#undef ROW
#undef VMW
#undef VMWN
#undef SLOAD_H
#undef SWRITE_HK
#undef SWRITE_HV
#undef SWRITE_H
#undef SLOAD_F
#undef SWRITE_KF
#undef SWRITE_VF

}

#define GAS __attribute__((address_space(1)))
#define LAS __attribute__((address_space(3)))
#define XB_TMO      128
#define XB_XCNT(j)  (256  + 64 * (j))
#define XB_XSUB(j)  (1280 + 64 * (j))
#define XB_XGEN(j)  (2304 + 64 * (j))
#define XB_TOP      3328
#define XB_TOPGEN   3392
#define XCD_BAR_WORDS 3456
#define XB_SPIN_CAP (1u << 18)

__device__ __forceinline__ unsigned xb_ld(unsigned* p)              { return __hip_atomic_load(p, __ATOMIC_RELAXED, __HIP_MEMORY_SCOPE_AGENT); }
__device__ __forceinline__ unsigned xb_add(unsigned* p, unsigned v) { return __hip_atomic_fetch_add(p, v, __ATOMIC_RELAXED, __HIP_MEMORY_SCOPE_AGENT); }
__device__ __forceinline__ unsigned xb_xcc_id() { return (unsigned)__builtin_amdgcn_s_getreg((3 << 11) | 20) & 0xFu; }
#define XB_SPIN(cond, bar) do { unsigned _sp = 0; while (cond) { __builtin_amdgcn_s_sleep(1); \
    if ((++_sp & 255u) == 0u) { if (xb_ld(&(bar)[XB_TMO])) break; if (_sp > XB_SPIN_CAP) { atomicAdd(&(bar)[XB_TMO], 1u); break; } } } } while (0)

struct XcdBarrier {
    unsigned* bar; unsigned x;
    volatile LAS unsigned* st;
};

__device__ __forceinline__ XcdBarrier xcd_barrier_post(unsigned* bar, volatile LAS unsigned* st) {
    XcdBarrier b; b.bar = bar; b.x = xb_xcc_id(); b.st = st;
    if (threadIdx.x == 0) (void)xb_add(&bar[XB_XCNT(b.x)], 1u);
    return b;
}
__device__ __forceinline__ void xcd_barrier_complete(unsigned* bar, unsigned x, unsigned& nloc, unsigned& nx) {
    const unsigned G = gridDim.x * gridDim.y * gridDim.z;
    unsigned sum, cnt, mine, sp = 0u;
    for (;;) {
        sum = 0u; cnt = 0u; mine = 0u;
#pragma unroll
        for (unsigned j = 0; j < 16; ++j) { const unsigned c = xb_ld(&bar[XB_XCNT(j)]); sum += c; cnt += (c > 0u) ? 1u : 0u; mine = (j == x) ? c : mine; }
        if (sum == G) break;
        __builtin_amdgcn_s_sleep(1);
        if ((++sp & 255u) == 0u) { if (xb_ld(&bar[XB_TMO])) break; if (sp > XB_SPIN_CAP) { atomicAdd(&bar[XB_TMO], 1u); break; } }
    }
    nloc = mine > 0u ? mine : 1u; nx = cnt > 0u ? cnt : 1u;
}

__device__ __forceinline__ void xcd_barrier(const XcdBarrier& b) {
    asm volatile("s_waitcnt vmcnt(0)" ::: "memory");
    __syncthreads();
    if (threadIdx.x == 0) {
        unsigned* bar = b.bar;
        __builtin_amdgcn_s_waitcnt(0);
        unsigned nloc = b.st[0], nx = b.st[1];
        if (nloc == 0u) { xcd_barrier_complete(bar, b.x, nloc, nx); b.st[0] = nloc; b.st[1] = nx; }
        const unsigned old = xb_add(&bar[XB_XSUB(b.x)], 1u);
        const unsigned gen = old / nloc;
        if (old + 1u == (gen + 1u) * nloc) {
            __builtin_amdgcn_fence(__ATOMIC_RELEASE, "agent");
            asm volatile("s_waitcnt vmcnt(0)" ::: "memory");
            const unsigned og = xb_add(&bar[XB_TOP], 1u);
            const unsigned tg = og / nx;
            if (og + 1u == (tg + 1u) * nx) xb_add(&bar[XB_TOPGEN], 1u);
            else XB_SPIN(xb_ld(&bar[XB_TOPGEN]) == tg, bar);
            __builtin_amdgcn_fence(__ATOMIC_ACQUIRE, "agent");
            xb_add(&bar[XB_XGEN(b.x)], 1u);
            asm volatile("s_waitcnt vmcnt(0)" ::: "memory");
        } else {
            XB_SPIN(xb_ld(&bar[XB_XGEN(b.x)]) == gen, bar);
            __builtin_amdgcn_fence(__ATOMIC_ACQUIRE, "agent");
            asm volatile("s_waitcnt vmcnt(0)" ::: "memory");
        }
    }
    __syncthreads();
}
namespace mk {
typedef unsigned short bf16;
typedef unsigned v4u __attribute__((ext_vector_type(4)));
typedef unsigned v2u __attribute__((ext_vector_type(2)));
typedef float f32x4 __attribute__((ext_vector_type(4)));
typedef short bf16x8 __attribute__((ext_vector_type(8)));
typedef GAS unsigned gu32;
#define RLX_AGENT __ATOMIC_RELAXED, __HIP_MEMORY_SCOPE_AGENT
#define LDS_WAIT() asm volatile("s_waitcnt lgkmcnt(0)" ::: "memory")
#define VM_WAIT() asm volatile("s_waitcnt vmcnt(0)" ::: "memory")

constexpr int D = 2048, NIN = 11264, DEPTH = 4, HK = 1024, NWAVES = 8, CH = 64, NCH = 8192 / CH;
constexpr int NPH_LAYER = 11, NPHASES = 1 + DEPTH * NPH_LAYER;
using namespace wsmap;
constexpr int CW_TMO = 0, CW_CODE = 1, CW_BAR = 4096;
constexpr int RING_OFF = 0, RING_BYTES = 131072, LDSCTL_OFF = RING_BYTES, MISC_OFF = LDSCTL_OFF + 320, LDS_BYTES = 147456;

struct Frame { LAS unsigned char* lds; gu32* ctl; int tid, lane, wave, gw, NGW, G, bid; };

__device__ __forceinline__ unsigned f2bf(float f) { unsigned u = __builtin_bit_cast(unsigned, f); return (u + 0x7fffu + ((u >> 16) & 1u)) >> 16; }
__device__ __forceinline__ unsigned pk2(float lo, float hi) { return pg8::cvt_pk_bf16(lo, hi); }
__device__ __forceinline__ float bfl(unsigned w) { return __uint_as_float(w << 16); }
__device__ __forceinline__ float bfh(unsigned w) { return __uint_as_float(w & 0xffff0000u); }
__device__ __forceinline__ float bf1(bf16 h) { return __uint_as_float(((unsigned)h) << 16); }
__device__ __forceinline__ float wave_sum(float v) {
#pragma unroll
    for (int o = 1; o < 64; o <<= 1) v += __shfl_xor(v, o);
    return v;
}

__device__ __forceinline__ void tr_item(const float* W, int K, int N, bf16* WT, int k0, int n0, int drow0, LAS unsigned* scr, int lane) {
    const int n4 = lane & 15, kq = lane >> 4;
    f32x4 a[8], b[8];
    const float* p = W + (size_t)(k0 + 2 * kq) * N + n0 + 4 * n4;
#pragma unroll
    for (int j = 0; j < 8; ++j) { a[j] = *(const GAS f32x4*)(p + (size_t)(8 * j) * N); b[j] = *(const GAS f32x4*)(p + (size_t)(8 * j + 1) * N); }
#pragma unroll
    for (int j = 0; j < 8; ++j)
#pragma unroll
        for (int i = 0; i < 4; ++i) scr[(4 * n4 + i) * 36 + 4 * j + kq] = pk2(a[j][i], b[j][i]);
    LDS_WAIT();
    const int c = lane & 7, rr = lane >> 3;
#pragma unroll
    for (int i = 0; i < 8; ++i) { const int n = 8 * i + rr; const v4u o = *(const LAS v4u*)(scr + n * 36 + 4 * c);
        *(GAS v4u*)(WT + (size_t)(drow0 + n) * K + k0 + 8 * c) = o; }
    LDS_WAIT();
}
template <bool HAS_Y, bool HAS_H>
__device__ __forceinline__ void norm_phase(Frame& F, const float* xin, const float* y, const float* wpost, float* xout, const float* wpre, bf16* hout) {
    for (int row = F.gw; row < S; row += F.NGW) {
        const GAS f32x4* xr = (const GAS f32x4*)(xin + (size_t)row * D) + F.lane;
        f32x4 xv[8];
#pragma unroll
        for (int j = 0; j < 8; ++j) xv[j] = xr[64 * j];
        if (HAS_Y) {
            const GAS f32x4* yr = (const GAS f32x4*)(y + (size_t)row * D) + F.lane;
            f32x4 yv[8]; float s = 0.f;
#pragma unroll
            for (int j = 0; j < 8; ++j) { yv[j] = yr[64 * j]; s += (yv[j].x * yv[j].x + yv[j].y * yv[j].y) + (yv[j].z * yv[j].z + yv[j].w * yv[j].w); }
            const float r = rsqrtf(wave_sum(s) * (1.f / D) + 1e-6f);
#pragma unroll
            for (int j = 0; j < 8; ++j) { const f32x4 w = ((const GAS f32x4*)wpost)[F.lane + 64 * j]; xv[j] = xv[j] + yv[j] * r * w; }
        }
        if (xout) { GAS f32x4* xo = (GAS f32x4*)(xout + (size_t)row * D) + F.lane;
#pragma unroll
            for (int j = 0; j < 8; ++j) xo[64 * j] = xv[j]; }
        if (HAS_H) {
            float s2 = 0.f;
#pragma unroll
            for (int j = 0; j < 8; ++j) s2 += (xv[j].x * xv[j].x + xv[j].y * xv[j].y) + (xv[j].z * xv[j].z + xv[j].w * xv[j].w);
            const float r2 = rsqrtf(wave_sum(s2) * (1.f / D) + 1e-6f);
            GAS v2u* ho = (GAS v2u*)(hout + (size_t)row * D) + F.lane;
#pragma unroll
            for (int j = 0; j < 8; ++j) { const f32x4 w = ((const GAS f32x4*)wpre)[F.lane + 64 * j]; const f32x4 h = xv[j] * r2 * w; ho[64 * j] = (v2u){pk2(h.x, h.y), pk2(h.z, h.w)}; }
        }
    }
}

constexpr int HL_TOT = 0, HL_VT = 2048, HL_KDT = 22528, HL_A = 22528, HL_QH = 43008, HL_KH = 89088, HL_SSQ = 121344;
constexpr int P64 = 160, P128 = 288;
static_assert(HL_SSQ + 512 <= RING_BYTES, "hgrn lds");
__device__ __forceinline__ bf16x8 ldsfrag(const LAS unsigned char* p) { return *(const LAS bf16x8*)p; }
#define MFMA16(a, b, c) __builtin_amdgcn_mfma_f32_16x16x32_bf16(a, b, c, 0, 0, 0)

__device__ __forceinline__ void hgrn_prefix(Frame& F, const float* LOGF, int c, int h, float (&p)[16]) {
    const int k = F.tid & 127, tg = F.tid >> 7;
    const float* src = LOGF + (size_t)(c * CH + 16 * tg) * HK + h * 128 + k;
    float run = 0.f;
#pragma unroll
    for (int i = 0; i < 16; ++i) p[i] = src[(size_t)i * HK];
#pragma unroll
    for (int i = 0; i < 16; ++i) { run += p[i]; p[i] = run; }
    ((LAS float*)(F.lds + HL_TOT))[tg * 128 + k] = run;
}
__device__ __forceinline__ void hgrn_c1_unit(Frame& F, int c, int h, const float* LOGF, const bf16* KK, const bf16* VH, float* HLOC, float* DEC) {
    const int k = F.tid & 127, tg = F.tid >> 7, fr = F.lane & 15, fq = F.lane >> 4;
    float p[16];
    hgrn_prefix(F, LOGF, c, h, p);
    const size_t g0 = (size_t)(c * CH + 16 * tg) * HK + h * 128 + k;
    float kv[16], vv[16];
#pragma unroll
    for (int i = 0; i < 16; ++i) { kv[i] = bf1(KK[g0 + (size_t)i * HK]); vv[i] = bf1(VH[g0 + (size_t)i * HK]); }
    __syncthreads();
    const LAS float* tot = (const LAS float*)(F.lds + HL_TOT);
    float off = 0.f, glast = 0.f;
#pragma unroll
    for (int g = 0; g < 4; ++g) { const float t = tot[g * 128 + k]; off += (g < tg) ? t : 0.f; glast += t; }
    unsigned wk[8], wv[8];
#pragma unroll
    for (int i = 0; i < 8; ++i) { const float e0 = __expf(glast - (off + p[2 * i])), e1 = __expf(glast - (off + p[2 * i + 1]));
        wk[i] = pk2(kv[2 * i] * e0, kv[2 * i + 1] * e1); wv[i] = pk2(vv[2 * i], vv[2 * i + 1]); }
    *(LAS v4u*)(F.lds + HL_KDT + k * P64 + 32 * tg) = (v4u){wk[0], wk[1], wk[2], wk[3]}; *(LAS v4u*)(F.lds + HL_KDT + k * P64 + 32 * tg + 16) = (v4u){wk[4], wk[5], wk[6], wk[7]};
    *(LAS v4u*)(F.lds + HL_VT + k * P64 + 32 * tg) = (v4u){wv[0], wv[1], wv[2], wv[3]}; *(LAS v4u*)(F.lds + HL_VT + k * P64 + 32 * tg + 16) = (v4u){wv[4], wv[5], wv[6], wv[7]};
    if (tg == 0) DEC[(size_t)c * HK + h * 128 + k] = __expf(glast);
    __syncthreads();
    const int w = F.wave;
    const bf16x8 x0 = ldsfrag(F.lds + HL_VT + (16 * w + fr) * P64 + fq * 16), x1 = ldsfrag(F.lds + HL_VT + (16 * w + fr) * P64 + 64 + fq * 16);
    float* dst = HLOC + ((size_t)(c * 8 + h) * 128 + 16 * w + fr) * 128 + 4 * fq;
#pragma unroll
    for (int kb = 0; kb < 8; ++kb) {
        const bf16x8 y0 = ldsfrag(F.lds + HL_KDT + (16 * kb + fr) * P64 + fq * 16), y1 = ldsfrag(F.lds + HL_KDT + (16 * kb + fr) * P64 + 64 + fq * 16);
        f32x4 acc = {0.f, 0.f, 0.f, 0.f};
        acc = MFMA16(y0, x0, acc); acc = MFMA16(y1, x1, acc);
        *(GAS f32x4*)(dst + 16 * kb) = acc;
    }
    __syncthreads();
}
__device__ __forceinline__ void hgrn_scan(Frame& F, const float* HLOC, const float* DEC, bf16* ST) {
    for (int e = F.bid * 512 + F.tid; e < 8 * 128 * 128; e += F.G * 512) {
        const int h = e >> 14, k = e & 127;
        const float* hp = HLOC + e; const float* dp = DEC + h * 128 + k; bf16* sp = ST + e;
        float st = 0.f;
        for (int c0 = 0; c0 < NCH; c0 += 8) {
            float hv[8], dv[8];
#pragma unroll
            for (int i = 0; i < 8; ++i) { hv[i] = hp[(size_t)(c0 + i) * (8 * 128 * 128)]; dv[i] = dp[(size_t)(c0 + i) * HK]; }
#pragma unroll
            for (int i = 0; i < 8; ++i) { sp[(size_t)(c0 + i) * (8 * 128 * 128)] = (bf16)f2bf(st); st = dv[i] * st + hv[i]; }
        }
    }
}
__device__ __forceinline__ int qrow(int r, int t) { return (r == 0 ? 0 : (r == 1 ? 64 : (r == 2 ? 112 : 144))) + t - 16 * r; }
__device__ __forceinline__ int krow(int r, int s) { return r == 0 ? s : (16 + 32 * (r - 1)) + s - 16 * (r - 1); }
__device__ __forceinline__ void hgrn_c3_unit(Frame& F, int c, int h, const float* LOGF, const bf16* QHg, const bf16* KK, const bf16* VH, const bf16* GHg, const bf16* ST, const float* gnw, bf16* OA) {
    const int k = F.tid & 127, tg = F.tid >> 7, fr = F.lane & 15, fq = F.lane >> 4, w = F.wave;
    const int ti = w & 3, vh = w >> 2;
    bf16x8 sf[4][4];
    { const bf16* sp = ST + ((size_t)(c * 8 + h) * 128 + vh * 64 + fr) * 128 + 8 * fq;
#pragma unroll
      for (int vb = 0; vb < 4; ++vb)
#pragma unroll
          for (int ks = 0; ks < 4; ++ks) sf[vb][ks] = *(const GAS bf16x8*)(sp + (size_t)vb * 16 * 128 + ks * 32); }
    float p[16];
    hgrn_prefix(F, LOGF, c, h, p);
    const size_t g0 = (size_t)(c * CH + 16 * tg) * HK + h * 128 + k;
    float qv[16], kv[16]; unsigned wv[8];
#pragma unroll
    for (int i = 0; i < 16; ++i) { qv[i] = bf1(QHg[g0 + (size_t)i * HK]); kv[i] = bf1(KK[g0 + (size_t)i * HK]); }
#pragma unroll
    for (int i = 0; i < 8; ++i) wv[i] = (unsigned)VH[g0 + (size_t)(2 * i) * HK] | ((unsigned)VH[g0 + (size_t)(2 * i + 1) * HK] << 16);
    *(LAS v4u*)(F.lds + HL_VT + k * P64 + 32 * tg) = (v4u){wv[0], wv[1], wv[2], wv[3]}; *(LAS v4u*)(F.lds + HL_VT + k * P64 + 32 * tg + 16) = (v4u){wv[4], wv[5], wv[6], wv[7]};
    __syncthreads();
    { const LAS float* tot = (const LAS float*)(F.lds + HL_TOT);
      float gb[4]; gb[0] = 0.f; gb[1] = tot[k]; gb[2] = gb[1] + tot[128 + k]; gb[3] = gb[2] + tot[256 + k];
      const float off = tg == 0 ? gb[0] : (tg == 1 ? gb[1] : (tg == 2 ? gb[2] : gb[3]));
      const float gnext = tg == 0 ? gb[1] : (tg == 1 ? gb[2] : gb[3]);
#pragma unroll
      for (int i = 0; i < 16; ++i) { const int t = 16 * tg + i; const float G = off + p[i];
#pragma unroll
          for (int r = 0; r < 4; ++r) if (r <= tg) *(LAS bf16*)(F.lds + HL_QH + qrow(r, t) * P128 + 2 * k) = (bf16)f2bf(qv[i] * __expf(G - gb[r]));
          *(LAS bf16*)(F.lds + HL_KH + krow(tg, t) * P128 + 2 * k) = (bf16)f2bf(kv[i] * __expf(off - G));
          if (tg < 3) *(LAS bf16*)(F.lds + HL_KH + krow(tg + 1, t) * P128 + 2 * k) = (bf16)f2bf(kv[i] * __expf(gnext - G)); } }
    __syncthreads();
#pragma unroll
    for (int bb = 0; bb < 2; ++bb) { const int b = 2 * w + bb, i = b >> 2, j = b & 3;
        f32x4 acc = {0.f, 0.f, 0.f, 0.f};
        if (j <= i) { const int r = (j < i) ? j + 1 : i;
            const LAS unsigned char* xp = F.lds + HL_QH + qrow(r, 16 * i + fr) * P128 + fq * 16; const LAS unsigned char* yp = F.lds + HL_KH + krow(r, 16 * j + fr) * P128 + fq * 16;
#pragma unroll
            for (int ks = 0; ks < 4; ++ks) acc = MFMA16(ldsfrag(yp + ks * 64), ldsfrag(xp + ks * 64), acc);
            const int lim = fr + (j == i ? 0 : 64);
#pragma unroll
            for (int jj = 0; jj < 4; ++jj) acc[jj] = (4 * fq + jj > lim) ? 0.f : acc[jj]; }
        *(LAS v2u*)(F.lds + HL_A + (16 * i + fr) * P64 + (16 * j + 4 * fq) * 2) = (v2u){pk2(acc[0], acc[1]), pk2(acc[2], acc[3])}; }
    __syncthreads();
    f32x4 o[4]; float ssq = 0.f;
    { const LAS unsigned char* ap = F.lds + HL_A + (16 * ti + fr) * P64 + fq * 16; const LAS unsigned char* qp = F.lds + HL_QH + (16 * ti + fr) * P128 + fq * 16;
      const bf16x8 a0 = ldsfrag(ap), a1 = ldsfrag(ap + 64), q0 = ldsfrag(qp), q1 = ldsfrag(qp + 64), q2 = ldsfrag(qp + 128), q3 = ldsfrag(qp + 192);
#pragma unroll
      for (int vb = 0; vb < 4; ++vb) { const LAS unsigned char* vp = F.lds + HL_VT + (vh * 64 + vb * 16 + fr) * P64 + fq * 16;
          f32x4 acc = {0.f, 0.f, 0.f, 0.f};
          acc = MFMA16(ldsfrag(vp), a0, acc); acc = MFMA16(ldsfrag(vp + 64), a1, acc);
          acc = MFMA16(sf[vb][0], q0, acc); acc = MFMA16(sf[vb][1], q1, acc); acc = MFMA16(sf[vb][2], q2, acc); acc = MFMA16(sf[vb][3], q3, acc);
          o[vb] = acc; ssq += (acc[0] * acc[0] + acc[1] * acc[1]) + (acc[2] * acc[2] + acc[3] * acc[3]); } }
    ssq += __shfl_xor(ssq, 16); ssq += __shfl_xor(ssq, 32);
    LAS float* sq = (LAS float*)(F.lds + HL_SSQ);
    if (fq == 0) sq[(16 * ti + fr) * 2 + vh] = ssq;
    __syncthreads();
    const float rinv = rsqrtf((sq[(16 * ti + fr) * 2] + sq[(16 * ti + fr) * 2 + 1]) * (1.f / 128.f) + 1e-6f);
    const size_t orow = (size_t)(c * CH + 16 * ti + fr) * HK + h * 128 + vh * 64 + 4 * fq;
#pragma unroll
    for (int vb = 0; vb < 4; ++vb) { const f32x4 gw4 = *(const GAS f32x4*)(gnw + vh * 64 + vb * 16 + 4 * fq); const v2u g = *(const GAS v2u*)(GHg + orow + vb * 16);
        const f32x4 r = {o[vb][0] * rinv * gw4[0] * bfl(g.x), o[vb][1] * rinv * gw4[1] * bfh(g.x), o[vb][2] * rinv * gw4[2] * bfl(g.y), o[vb][3] * rinv * gw4[3] * bfh(g.y)};
        *(GAS v2u*)(OA + orow + vb * 16) = (v2u){pk2(r[0], r[1]), pk2(r[2], r[3])}; }
    __syncthreads();
}
__device__ __forceinline__ void attn_combine(Frame& F, const bf16* AO, const float* subw, float lam, float lam_init, bf16* OB) {
    const int half = F.lane >> 5, d = (4 * F.lane) & 127;
    const f32x4 sw = *(const GAS f32x4*)(subw + 4 * F.lane);
    for (int it = F.gw; it < S * 4; it += F.NGW) { const int s = it >> 2, h = it & 3;
        const v2u a0 = *(const GAS v2u*)(AO + ((size_t)((h * 2 + 0) * 2 + half) * S + s) * 128 + d), a1 = *(const GAS v2u*)(AO + ((size_t)((h * 2 + 1) * 2 + half) * S + s) * 128 + d);
        const f32x4 o = {bfl(a0.x) - lam * bfl(a1.x), bfh(a0.x) - lam * bfh(a1.x), bfl(a0.y) - lam * bfl(a1.y), bfh(a0.y) - lam * bfh(a1.y)};
        const float r = rsqrtf(wave_sum((o[0] * o[0] + o[1] * o[1]) + (o[2] * o[2] + o[3] * o[3])) * (1.f / 256.f) + 1e-5f) * (1.f - lam_init);
        *(GAS v2u*)(OB + (size_t)s * HK + h * 256 + 4 * F.lane) = (v2u){pk2(o[0] * r * sw[0], o[1] * r * sw[1]), pk2(o[2] * r * sw[2], o[3] * r * sw[3])}; }
}
struct Args { const float* in[12]; float* out; unsigned char* ws; int ph_lo, ph_hi; };
__global__ void __launch_bounds__(NWAVES * 64, 2) mk_fwd(Args args) {
    extern __shared__ __attribute__((aligned(16))) unsigned char lds[];
    { const int t0 = threadIdx.x;
      for (int u = t0; u < (LDS_BYTES - LDSCTL_OFF) / 4; u += NWAVES * 64) ((LAS unsigned*)((LAS unsigned char*)lds + LDSCTL_OFF))[u] = 0u;
      __syncthreads();
      (void)xcd_barrier_post((unsigned*)(args.ws + WS_CTL) + CW_BAR, (volatile LAS unsigned*)((LAS unsigned char*)lds + MISC_OFF) + 8); }
#define GRID_BAR() do { { XcdBarrier bar_; bar_.bar = (unsigned*)(F.ctl + CW_BAR); bar_.x = xb_xcc_id(); bar_.st = (volatile LAS unsigned*)(F.lds + MISC_OFF) + 8; xcd_barrier(bar_); } } while (0)
    const int lo = args.ph_lo, hi = args.ph_hi;
#define IN(k) (lo <= (k) && (k) < hi)
#define BOTH(k) (IN(k) && IN((k) + 1))
#ifndef MK_EN
#define MK_EN 0xfff
#endif
#define EN(j) (((MK_EN) >> (j)) & 1)
#define PHASE_ENV() \
    const __attribute__((address_space(4))) Args* ka_ = (const __attribute__((address_space(4))) Args*)__builtin_amdgcn_kernarg_segment_ptr(); asm volatile("" : "+s"(ka_)); \
    unsigned char* const ws = ka_->ws; float* const X = ka_->out; (void)X; \
    int tid_e = threadIdx.x; asm volatile("" : "+v"(tid_e)); \
    Frame F; F.lds = (LAS unsigned char*)lds; F.ctl = (gu32*)(ws + WS_CTL); F.tid = tid_e; F.lane = tid_e & 63; F.wave = __builtin_amdgcn_readfirstlane(tid_e >> 6); \
    { int bid_e = blockIdx.x; asm volatile("" : "+s"(bid_e)); F.bid = bid_e; } F.G = gridDim.x; F.gw = F.bid * NWAVES + F.wave; F.NGW = F.G * NWAVES; \
    bf16* const Hb = (bf16*)(ws + WS_H); bf16* const QH = (bf16*)(ws + WS_QH); bf16* const KK = (bf16*)(ws + WS_KK); float* const LOGF = (float*)(ws + WS_LOGF); bf16* const VH = (bf16*)(ws + WS_VH); bf16* const GH = (bf16*)(ws + WS_GH); \
    bf16* const DQ = (bf16*)(ws + WS_DQ); bf16* const DK = (bf16*)(ws + WS_DK); bf16* const DV = (bf16*)(ws + WS_DV); bf16* const GA = (bf16*)(ws + WS_GA); bf16* const GB = (bf16*)(ws + WS_GB); \
    float* const HLOC = (float*)(ws + WS_HLOC); bf16* const ST = (bf16*)(ws + WS_ST); float* const DEC = (float*)(ws + WS_DEC); bf16* const AO = (bf16*)(ws + WS_AO); bf16* const OA = (bf16*)(ws + WS_OA); bf16* const OB = (bf16*)(ws + WS_OB); \
    bf16* const MERGED = (bf16*)(ws + WS_MERGED); float* const Y = (float*)(ws + WS_Y); bf16* const ACT = (bf16*)(ws + WS_ACT); \
    float* const COS = (float*)(ws + WS_COS); float* const SIN = (float*)(ws + WS_SIN); float* const LB = (float*)(ws + WS_LB); float* const LAM = (float*)(ws + WS_LAM); \
    (void)Hb; (void)QH; (void)KK; (void)LOGF; (void)VH; (void)GH; (void)DQ; (void)DK; (void)DV; (void)GA; (void)GB; (void)HLOC; (void)ST; (void)DEC; (void)AO; (void)OA; (void)OB; (void)MERGED; (void)Y; (void)ACT; (void)COS; (void)SIN; (void)LB; (void)LAM; \
    unsigned char* const wl = ws + WS_W + (size_t)l * W_LAYER; const float* const nw = ka_->in[9] + (size_t)l * 4 * D; (void)wl; (void)nw
#define AIN(i) (ka_->in[i])
    if (EN(0) && IN(0)) {
        constexpr int l = 0; PHASE_ENV();
        LAS unsigned* scr = (LAS unsigned*)(F.lds + RING_OFF + F.wave * 9216);
        constexpr int I_IN = 32 * 176, I_A = 16 * 32, I_OUT = 32 * 32, I_FO = 88 * 32, I_LAYER = 2 * I_IN + 2 * I_A + I_OUT + I_FO;
        for (int it = F.gw; it < DEPTH * I_LAYER; it += F.NGW) {
            const int ly = it / I_LAYER; int r = it - ly * I_LAYER;
            unsigned char* wly = ws + WS_W + (size_t)ly * W_LAYER;
            if (r < I_IN) { const int kb = r / 176, nb = r - kb * 176; tr_item(AIN(1) + (size_t)ly * D * NIN, D, NIN, (bf16*)(wly + WO_IN), 64 * kb, 64 * nb, 64 * nb, scr, F.lane); continue; } r -= I_IN;
            if (r < I_A) { const int kb = r / 32, nb = r - kb * 32; tr_item(AIN(6) + (size_t)ly * HK * D, HK, D, (bf16*)(wly + WO_A), 64 * kb, 64 * nb, 64 * nb, scr, F.lane); continue; } r -= I_A;
            if (r < I_A) { const int kb = r / 32, nb = r - kb * 32; tr_item(AIN(7) + (size_t)ly * HK * D, HK, D, (bf16*)(wly + WO_B), 64 * kb, 64 * nb, 64 * nb, scr, F.lane); continue; } r -= I_A;
            if (r < I_OUT) { const int kb = r / 32, nb = r - kb * 32; tr_item(AIN(8) + (size_t)ly * D * D, D, D, (bf16*)(wly + WO_OUT), 64 * kb, 64 * nb, 64 * nb, scr, F.lane); continue; } r -= I_OUT;
            if (r < I_IN) { const int kb = r / 176, nb = r - kb * 176; const int n0 = 64 * nb, j = n0 < FF ? n0 : n0 - FF;
                            tr_item(AIN(10) + (size_t)ly * D * NIN, D, NIN, (bf16*)(wly + WO_FI), 64 * kb, n0, (j >> 7) * 256 + (n0 < FF ? 0 : 128) + (j & 127), scr, F.lane); continue; } r -= I_IN;
            { const int kb = r / 32, nb = r - kb * 32; tr_item(AIN(11) + (size_t)ly * FF * D, FF, D, (bf16*)(wly + WO_FO), 64 * kb, 64 * nb, 64 * nb, scr, F.lane); }
        }
        { const int pos = F.bid * 512 + F.tid;
          if (pos < S) {
              constexpr float invf[16] = {1.0f, 0.44036659598350525f, 0.1939227432012558f, 0.08539710193872452f, 0.03760603070259094f, 0.01656043902039528f, 0.007292664609849453f, 0.0032114458736032248f,
                                          0.0014142135623842478f, 0.000622772378847003f, 0.00027424818836152554f, 0.00012076973507646471f, 5.318296098266728e-05f, 2.34199997066753e-05f, 1.0313386155758053e-05f, 4.541670477919979e-06f};
              float cs[16], sn[16];
#pragma unroll
              for (int i = 0; i < 16; ++i) { const float ang = (float)pos * invf[i]; double rev = (double)ang * 0.15915494309189535; rev -= __builtin_floor(rev);
                  cs[i] = __builtin_amdgcn_cosf((float)rev); sn[i] = __builtin_amdgcn_sinf((float)rev); }
#pragma unroll
              for (int i = 0; i < 4; ++i) { *(GAS f32x4*)(COS + pos * 16 + 4 * i) = (f32x4){cs[4 * i], cs[4 * i + 1], cs[4 * i + 2], cs[4 * i + 3]};
                                            *(GAS f32x4*)(SIN + pos * 16 + 4 * i) = (f32x4){sn[4 * i], sn[4 * i + 1], sn[4 * i + 2], sn[4 * i + 3]}; } } }
        if (F.bid == F.G - 1) {
            for (int ch = F.tid; ch < HK; ch += NWAVES * 64) { const float* b = AIN(2) + ch; const float v0 = b[0], v1 = b[HK], v2 = b[2 * HK], v3 = b[3 * HK];
                const float mx = fmaxf(fmaxf(v0, v1), fmaxf(v2, v3)); const float e0 = __expf(v0 - mx), e1 = __expf(v1 - mx), e2 = __expf(v2 - mx), e3 = __expf(v3 - mx); const float inv = 1.f / (e0 + e1 + e2 + e3);
                LB[ch] = 0.f; LB[HK + ch] = e1 * inv; LB[2 * HK + ch] = (e1 + e2) * inv; LB[3 * HK + ch] = (e1 + e2 + e3) * inv; }
            if (F.wave < DEPTH) { const float* lp = AIN(4) + F.wave * 512; const int i = F.lane;
                const float s1 = wave_sum(lp[i] * lp[128 + i] + lp[64 + i] * lp[192 + i]), s2 = wave_sum(lp[256 + i] * lp[384 + i] + lp[320 + i] * lp[448 + i]);
                if (F.lane == 0) LAM[F.wave] = __expf(s1) - __expf(s2) + (0.8f - 0.6f * __expf(-0.3f * (float)F.wave)); }
        }
        norm_phase<false, true>(F, AIN(0), nullptr, nullptr, X, AIN(9), Hb);
        if (BOTH(0)) GRID_BAR();
    }

    for (int l = 0; l < DEPTH; ++l) {
        const int pb = 1 + l * NPH_LAYER;
        if (EN(1) && IN(pb + 0)) {
            PHASE_ENV();
            pg8::Gemm g{Hb, (const bf16*)(wl + WO_IN), S, NIN, D}; pg8::StaticOrder So; So.init(S, NIN, F.G, F.bid);
            pg8::EpiIn E{ws, LB + l * HK};
            pg8::gemm_phase<pg8::EpiIn, pg8::StaticOrder, true, true>(F.lds + RING_OFF, g, So, E);
            if (BOTH(pb + 0)) GRID_BAR();
        }
        if (EN(2) && IN(pb + 1)) {
            PHASE_ENV();
            for (int u = F.bid; u < NCH * 8; u += F.G) hgrn_c1_unit(F, u >> 3, u & 7, LOGF, KK, VH, HLOC, DEC);
            if (BOTH(pb + 1)) GRID_BAR();
        }
        if (EN(3) && IN(pb + 2)) {
            PHASE_ENV();
            hgrn_scan(F, HLOC, DEC, ST);
            if (BOTH(pb + 2)) GRID_BAR();
        }
        if (EN(4) && IN(pb + 3)) {
            PHASE_ENV();
#ifdef MK_C3PASS
            for (size_t e = (size_t)F.bid * 512 + F.tid; e < (size_t)S * HK; e += (size_t)F.G * 512) OA[e] = (bf16)f2bf(bf1(QH[e]) + bf1(KK[e]) + bf1(VH[e]) + bf1(GH[e]) + LOGF[e]);
#elif !defined(MK_NOC3)
            for (int u = F.bid; u < NCH * 8; u += F.G) hgrn_c3_unit(F, u >> 3, u & 7, LOGF, QH, KK, VH, GH, ST, AIN(3) + l * 128, OA);
#endif
#ifndef MK_NOATT
            {
                using att::bf16; typedef att::BlockRef<att::bf16, att::bf16> BR;
                const int total = 256, stride = F.G;
                int L = F.bid;
                if (L < total) {
                    int pass = 0;
                    auto mkref = [&](int L_, int pass_) { const int sidx = (L_ & 7) * 2 + (L_ >> 7), xq = (L_ >> 3) & 15, qb = pass_ ? 31 - xq : xq; BR r;
                        r.Q = (const att::bf16*)DQ + ((size_t)(sidx >> 1) * S + (size_t)qb * 256) * 128; r.K = (const att::bf16*)DK + (size_t)(sidx >> 1) * S * 128;
                        r.V = (const att::bf16*)DV + (size_t)((sidx >> 2) * 2 + (sidx & 1)) * S * 128; r.O = (att::bf16*)AO + ((size_t)sidx * S + (size_t)qb * 256) * 128; r.P0 = qb * 256; return r; };
                    BR cur = mkref(L, 0);
                    att::Seam<att::bf16> Sm;
                    att::causal_swa_prime<att::bf16, att::bf16>(cur, 1 << 30, (char*)lds + RING_OFF, Sm);
                    for (;;) {
                        const bool more_pass = pass == 0, more_item = L + stride < total, last = !more_pass && !more_item;
                        int passn = pass + 1, Ln = L;
                        if (!more_pass) { passn = 0; Ln = more_item ? L + stride : L; }
                        const BR nxt = last ? cur : mkref(Ln, passn);
                        att::causal_swa_block<att::bf16, att::bf16>(cur, nxt, S, 1 << 30, (char*)lds + RING_OFF, Sm);
                        if (last) break;
                        cur = nxt; pass = passn; L = Ln;
                    }
                }
            }
#endif
            if (BOTH(pb + 3)) GRID_BAR();
        }
        if (EN(5) && IN(pb + 4)) {
            PHASE_ENV();
            const float lam = __hip_atomic_load((GAS float*)LAM + l, RLX_AGENT);
            attn_combine(F, AO, AIN(5) + l * 256, lam, 0.8f - 0.6f * __expf(-0.3f * (float)l), OB);
            if (BOTH(pb + 4)) GRID_BAR();
        }
        if (EN(6) && IN(pb + 5)) {
            PHASE_ENV();
            { pg8::Gemm g{OA, (const bf16*)(wl + WO_A), S, D, HK}; pg8::StaticOrder So; So.init(S, D, F.G, F.bid); pg8::EpiGate1 E{Y, GA};
              pg8::gemm_phase<pg8::EpiGate1, pg8::StaticOrder, true, true>(F.lds + RING_OFF, g, So, E); }
            { pg8::Gemm g{OB, (const bf16*)(wl + WO_B), S, D, HK}; pg8::StaticOrder So; So.init(S, D, F.G, F.bid); pg8::EpiGate2 E{Y, GB, MERGED};
              pg8::gemm_phase<pg8::EpiGate2, pg8::StaticOrder, true, true>(F.lds + RING_OFF, g, So, E); }
            if (BOTH(pb + 5)) GRID_BAR();
        }
        if (EN(7) && IN(pb + 6)) {
            PHASE_ENV();
            pg8::Gemm g{MERGED, (const bf16*)(wl + WO_OUT), S, D, D}; pg8::StaticOrder So; So.init(S, D, F.G, F.bid); pg8::EpiF32 E{Y, D};
            pg8::gemm_phase<pg8::EpiF32, pg8::StaticOrder, true, true>(F.lds + RING_OFF, g, So, E);
            if (BOTH(pb + 6)) GRID_BAR();
        }
        if (EN(8) && IN(pb + 7)) {
            PHASE_ENV();
            norm_phase<true, true>(F, X, Y, nw + D, X, nw + 2 * D, Hb);
            if (BOTH(pb + 7)) GRID_BAR();
        }
        if (EN(9) && IN(pb + 8)) {
            PHASE_ENV();
            pg8::Gemm g{Hb, (const bf16*)(wl + WO_FI), S, NIN, D}; pg8::StaticOrder So; So.init(S, NIN, F.G, F.bid); pg8::EpiSwiglu E{ACT};
            pg8::gemm_phase<pg8::EpiSwiglu, pg8::StaticOrder, true, true>(F.lds + RING_OFF, g, So, E);
            if (BOTH(pb + 8)) GRID_BAR();
        }
        if (EN(10) && IN(pb + 9)) {
            PHASE_ENV();
            pg8::Gemm g{ACT, (const bf16*)(wl + WO_FO), S, D, FF}; pg8::StaticOrder So; So.init(S, D, F.G, F.bid); pg8::EpiF32 E{Y, D};
            pg8::gemm_phase<pg8::EpiF32, pg8::StaticOrder, true, true>(F.lds + RING_OFF, g, So, E);
            if (BOTH(pb + 9)) GRID_BAR();
        }
        if (EN(11) && IN(pb + 10)) {
            PHASE_ENV();
            if (l + 1 < DEPTH) norm_phase<true, true>(F, X, Y, nw + 3 * D, X, nw + 4 * D, Hb);
            else norm_phase<true, false>(F, X, Y, nw + 3 * D, X, nullptr, nullptr);
            if (BOTH(pb + 10)) GRID_BAR();
        }
    }
#undef IN
#undef BOTH
}
}

extern "C" void kernel_launch(void* const* d_in, const int* in_sizes, int n_in, void* d_out, int out_size, void* d_ws, size_t ws_size, hipStream_t stream) {
    using namespace mk;
    static int grid = 0;
    if (grid == 0) {
        if (n_in != 12 || in_sizes[0] != S * D || out_size != S * D || ws_size < WS_END) { fprintf(stderr, "kernel_launch: shape/workspace mismatch (n_in %d, in0 %d, out %d, ws %zu; need ws >= %zu); nothing launched\n", n_in, n_in > 0 ? in_sizes[0] : -1, out_size, ws_size, (size_t)WS_END); grid = -1; return; }
        int dev = 0, cus = 0, per_cu = 0;
        if (hipGetDevice(&dev) != hipSuccess || hipDeviceGetAttribute(&cus, hipDeviceAttributeMultiprocessorCount, dev) != hipSuccess) { grid = -1; return; }
        if (hipFuncSetAttribute((const void*)mk_fwd, hipFuncAttributeMaxDynamicSharedMemorySize, LDS_BYTES) != hipSuccess) { fprintf(stderr, "kernel_launch: hipFuncSetAttribute failed\n"); grid = -1; return; }
        if (hipOccupancyMaxActiveBlocksPerMultiprocessor(&per_cu, (const void*)mk_fwd, NWAVES * 64, LDS_BYTES) != hipSuccess || per_cu < 1) fprintf(stderr, "kernel_launch: note: occupancy query reports %d workgroups per CU\n", per_cu);
        (void)hipGetLastError();
        grid = cus;
    }
    if (grid < 0) return;
    if (hipMemsetAsync((char*)d_ws + WS_CTL, 0, CTL_ZERO_BYTES, stream) != hipSuccess) return;
    Args a{};
    for (int i = 0; i < 12; ++i) a.in[i] = (const float*)d_in[i];
    a.out = (float*)d_out; a.ws = (unsigned char*)d_ws;
#if MK_PER_PHASE
    for (int p = 0; p < NPHASES; ++p) { a.ph_lo = p; a.ph_hi = p + 1; hipLaunchKernelGGL(mk_fwd, dim3(grid), dim3(NWAVES * 64), LDS_BYTES, stream, a); }
#else
    a.ph_lo = 0; a.ph_hi = NPHASES;
    hipLaunchKernelGGL(mk_fwd, dim3(grid), dim3(NWAVES * 64), LDS_BYTES, stream, a);
#endif
}
```
